# Optimizing an MI355X kernel written in HIP

```python
import jax, jax.numpy as jnp
from jax import lax
import numpy as np

D_MODEL = 1024
BATCH = 8
SEQ = 2048
DEPTH = 1

D_MIX = 2 * D_MODEL
D_A = D_MIX // 2
D_B = D_MIX - D_A
A_GROUPS = 8
A_GROUP_DIM = D_A // A_GROUPS
A_CHUNK = 128
B_HEADS = 4
B_DK = D_B // 2 // B_HEADS
B_DV = D_B // B_HEADS
B_GATE_RANK = 16
B_GATE_TAU = 16.0
B_CHUNK = 64
D_IN = 3 * D_A + 2 * B_HEADS * B_DK + 2 * D_B + B_GATE_RANK
EPS = 1e-6

kernel_name = "hybrid_gmlp_gla_parallel_heads"


def rmsnorm(x, g):
    xf = x.astype(jnp.float32)
    y = xf * lax.rsqrt(jnp.mean(xf * xf, axis=-1, keepdims=True) + EPS)
    return (y * g.astype(jnp.float32)).astype(x.dtype)


def layernorm(x, g, b):
    xf = x.astype(jnp.float32)
    mu = jnp.mean(xf, axis=-1, keepdims=True)
    xc = xf - mu
    y = xc * lax.rsqrt(jnp.mean(xc * xc, axis=-1, keepdims=True) + EPS)
    return (y * g.astype(jnp.float32) + b.astype(jnp.float32)).astype(x.dtype)


def chunked_sgu(u, v, ln_g, ln_b, w_s, b_s):
    bsz, s = u.shape[:2]
    n = s // A_CHUNK
    vn = layernorm(v, ln_g, ln_b).reshape(bsz, n, A_CHUNK, A_GROUPS, A_GROUP_DIM)
    causal = jnp.tril(jnp.ones((A_CHUNK, A_CHUNK), dtype=bool))
    w = jnp.where(causal[None], w_s, jnp.zeros_like(w_s))
    sp = jnp.einsum('gts,bnsgc->bntgc', w, vn) + b_s.T[None, None, :, :, None]
    return u * sp.reshape(bsz, s, D_A).astype(u.dtype)


def gla_chunked(q, k, v, log_a):
    bsz, s = q.shape[:2]
    n = s // B_CHUNK
    f32 = jnp.float32

    def blk(t, d):
        return t.astype(f32).reshape(bsz, n, B_CHUNK, B_HEADS, d).transpose(0, 3, 1, 2, 4)

    q = blk(q, B_DK) * (B_DK ** -0.5)
    k = blk(k, B_DK)
    v = blk(v, B_DV)
    b = jnp.cumsum(blk(log_a, B_DK), axis=3)
    b_last = b[:, :, :, -1:, :]
    b_ref = b[:, :, :, B_CHUNK // 2 - 1:B_CHUNK // 2, :]

    qe = q * jnp.exp(b - b_ref)
    ke = k * jnp.exp(b_ref - b)
    scores = jnp.einsum('bhncd,bhnsd->bhncs', qe, ke)
    causal = jnp.tril(jnp.ones((B_CHUNK, B_CHUNK), dtype=bool))
    scores = jnp.where(causal, scores, 0.0)
    o_intra = jnp.einsum('bhncs,bhnsv->bhncv', scores, v)

    chunk_kv = jnp.einsum('bhncd,bhncv->bhndv', k * jnp.exp(b_last - b), v)
    decay = jnp.exp(b_last[:, :, :, 0, :])

    def step(state, inp):
        dec, kv = inp
        return dec[..., None] * state + kv, state

    s0 = jnp.zeros((bsz, B_HEADS, B_DK, B_DV), f32)
    _, s_prev = lax.scan(step, s0, (decay.transpose(2, 0, 1, 3), chunk_kv.transpose(2, 0, 1, 3, 4)))
    s_prev = s_prev.transpose(1, 2, 0, 3, 4)
    o_inter = jnp.einsum('bhncd,bhndv->bhncv', q * jnp.exp(b), s_prev)

    o = o_intra + o_inter
    return o.transpose(0, 2, 3, 1, 4).reshape(bsz, s, B_HEADS, B_DV)


def hybrid_layer(x, pre_g, w_in, w_a2, b_a2, a_ln_g, a_ln_b, a_w_s, a_b_s, b_norm_g, w_out, post_g):
    bsz, s, _ = x.shape
    h = rmsnorm(x, pre_g)
    z = jnp.einsum('bsd,de->bse', h, w_in)
    sizes = [D_A, D_A, D_A, B_HEADS * B_DK, B_HEADS * B_DK, D_B, D_B, B_GATE_RANK]
    cuts = np.cumsum(sizes)[:-1].tolist()
    a_u, a_v, a_gate, b_q, b_k, b_v, b_gate, b_lr = jnp.split(z, cuts, axis=-1)

    a_out = chunked_sgu(jax.nn.gelu(a_u, approximate=False), jax.nn.gelu(a_v, approximate=False),
                        a_ln_g, a_ln_b, a_w_s, a_b_s)
    a_out = a_out * jax.nn.silu(a_gate)

    gate_logit = jnp.einsum('bsr,re->bse', b_lr.astype(jnp.float32), w_a2.astype(jnp.float32)) + b_a2.astype(jnp.float32)
    log_a = jax.nn.log_sigmoid(gate_logit) / B_GATE_TAU
    o = gla_chunked(b_q.reshape(bsz, s, B_HEADS, B_DK), b_k.reshape(bsz, s, B_HEADS, B_DK),
                    b_v.reshape(bsz, s, B_HEADS, B_DV), log_a.reshape(bsz, s, B_HEADS, B_DK))
    o = rmsnorm(o, b_norm_g.reshape(B_HEADS, B_DV)).reshape(bsz, s, D_B).astype(x.dtype)
    b_out = o * jax.nn.silu(b_gate)

    mixed = jnp.concatenate([a_out, b_out], axis=-1)
    y = jnp.einsum('bse,ed->bsd', mixed, w_out)
    return x + rmsnorm(y, post_g)


def setup_inputs(seed: int = 0) -> dict:
    key = jax.random.key(seed)
    ks = jax.random.split(key, 13)
    f32 = jnp.float32
    nrm = lambda k, shp, sc: jax.random.normal(k, shp, f32) * sc
    return {
        "x": jax.random.normal(ks[0], (BATCH, SEQ, D_MODEL), f32),
        "pre_norm_g": 1.0 + nrm(ks[1], (DEPTH, D_MODEL), 0.02),
        "w_in": nrm(ks[2], (DEPTH, D_MODEL, D_IN), D_MODEL ** -0.5),
        "w_a2": nrm(ks[3], (DEPTH, B_GATE_RANK, B_HEADS * B_DK), B_GATE_RANK ** -0.5),
        "b_a2": nrm(ks[4], (DEPTH, B_HEADS * B_DK), 0.1),
        "a_ln_g": 1.0 + nrm(ks[5], (DEPTH, D_A), 0.02),
        "a_ln_b": nrm(ks[6], (DEPTH, D_A), 0.02),
        "a_w_s": nrm(ks[7], (DEPTH, A_GROUPS, A_CHUNK, A_CHUNK), A_CHUNK ** -0.5),
        "a_b_s": 1.0 + nrm(ks[8], (DEPTH, A_GROUPS, A_CHUNK), 0.02),
        "b_norm_g": 1.0 + nrm(ks[9], (DEPTH, D_B), 0.02),
        "w_out": nrm(ks[10], (DEPTH, D_MIX, D_MODEL), D_MIX ** -0.5),
        "post_norm_g": 1.0 + nrm(ks[11], (DEPTH, D_MODEL), 0.02),
    }


def reference(x, pre_norm_g, w_in, w_a2, b_a2, a_ln_g, a_ln_b, a_w_s, a_b_s, b_norm_g, w_out, post_norm_g):
    for l in range(DEPTH):
        x = hybrid_layer(x, pre_norm_g[l], w_in[l], w_a2[l], b_a2[l], a_ln_g[l], a_ln_b[l],
                         a_w_s[l], a_b_s[l], b_norm_g[l], w_out[l], post_norm_g[l])
    return x
```

```cpp
#include <hip/hip_runtime.h>
#include <cstdio>
#include <cstdint>
namespace pg8 {
#define PG8_LAS __attribute__((address_space(3)))
typedef unsigned short bf16_t;
typedef short bf16x8 __attribute__((ext_vector_type(8)));
typedef float f32x4 __attribute__((ext_vector_type(4)));
typedef float f32x2 __attribute__((ext_vector_type(2)));
typedef unsigned u32x4 __attribute__((ext_vector_type(4)));
typedef unsigned u32x2 __attribute__((ext_vector_type(2)));
constexpr int BM = 256, BK = 64, HALF = 128, HTB = HALF * BK * 2  , STAGE_BYTES = 8 * HTB, NXCD = 8, WGM = 8;

__host__ __device__ __forceinline__ int lds_byte(int r, int c) { const int st = (r >> 4) * 2 + (c >> 5), rr = r & 15, cc = c & 31, ob = rr * 64 + cc * 2; return st * 1024 + (ob ^ (((ob >> 9) & 1) << 5)); }
__host__ __device__ __forceinline__ void stage_rc(int b, int& R, int& C) { const int st = b / 1024, sb = b % 1024, swz = sb ^ (((sb >> 9) & 1) << 5); R = (st >> 1) * 16 + swz / 64; C = (st & 1) * 32 + (swz % 64) / 2; }
__host__ __device__ __forceinline__ int perm32(int rho) { const int n = rho >> 4, i = rho & 15; return 8 * (i >> 2) + 4 * n + (i & 3); }

struct Unit { int pm, pn; };
struct Gemm { const bf16_t* A; const bf16_t* A2; const bf16_t* Bt; int M, N, K, lda, ksplit; };

struct StaticOrder {
    int nM, nN, nwg, G, c;
    __host__ __device__ void init(int M, int N, int G_, int c_) { nM = M / BM; nN = N / BM; nwg = nM * nN; G = G_; c = c_; }
    __host__ __device__ bool next(int i, Unit& u) const {
        const long L = (long)i * G + c; if (L >= nwg) return false;
        int wgid = (int)L; { const int q = nwg / NXCD, r = nwg % NXCD, xcd = wgid % NXCD, off = wgid / NXCD; wgid = (xcd < r ? xcd * (q + 1) : r * (q + 1) + (xcd - r) * q) + off; }
        const int nig = WGM * nN, gid = wgid / nig, fm = gid * WGM, gsz = (nM - fm) < WGM ? (nM - fm) : WGM;
        u.pm = fm + ((wgid % nig) % gsz); u.pn = (wgid % nig) / gsz; return true;
    }
    __device__ __forceinline__ void a_ready(const Unit&) const {}
    __device__ __forceinline__ void done(const Unit&) const {}
};

__device__ __forceinline__ unsigned cvt_pk_bf16(float lo, float hi) { unsigned r; asm volatile("v_cvt_pk_bf16_f32 %0, %1, %2" : "=v"(r) : "v"(lo), "v"(hi)); return r; }
__device__ __forceinline__ f32x2 gelu_pk(f32x2 v) {
    const f32x2 av = __builtin_elementwise_abs(v), d = av * 0.2316418882f + 1.0f;
    f32x2 t; t.x = __builtin_amdgcn_rcpf(d.x); t.y = __builtin_amdgcn_rcpf(d.y);
    f32x2 q = t * 0.5307027145f + (-0.7265760135f); q = q * t + 0.7107068705f; q = q * t + (-0.142248368f); q = q * t + 0.127414796f; q = q * t;
    const f32x2 s = (v * v) * (-0.72134752044f);
    f32x2 e; e.x = __builtin_amdgcn_exp2f(s.x); e.y = __builtin_amdgcn_exp2f(s.y);
    const f32x2 m = v * (q * e), r = v - m;
    f32x2 o; o.x = v.x < 0.f ? m.x : r.x; o.y = v.y < 0.f ? m.y : r.y; return o;
}
__device__ __forceinline__ float silu_f(float x) { return x * __builtin_amdgcn_rcpf(1.0f + __builtin_amdgcn_exp2f(x * -1.4426950408889634f)); }
template <int ACT> __device__ __forceinline__ f32x4 act4(f32x4 v) {
    if (ACT == 1) { f32x2 a = gelu_pk((f32x2){v[0], v[1]}), b = gelu_pk((f32x2){v[2], v[3]}); return (f32x4){a.x, a.y, b.x, b.y}; }
    if (ACT == 2) { return (f32x4){silu_f(v[0]), silu_f(v[1]), silu_f(v[2]), silu_f(v[3])}; }
    if (ACT == 3) { return v * 0.08838834764831845f; }
    return v;
}

struct EpiZ {
    static constexpr bool PERM = true, AFTER_DRAIN = false;
    bf16_t* Z; int ldc;
    template <int ACT> __device__ __forceinline__ void run(const f32x4 (&acc)[2][2][4][2], const Unit& u, int wr, int wc, int fr, int fq) const {
        const int row0 = u.pm * BM + wr * 64 + fr, col0 = u.pn * BM + wc * 32 + 8 * fq;
#pragma unroll
        for (int ai = 0; ai < 2; ++ai)
#pragma unroll
            for (int m = 0; m < 4; ++m) { bf16_t* rowp = Z + (size_t)(row0 + ai * HALF + m * 16) * ldc + col0;
#pragma unroll
                for (int bj = 0; bj < 2; ++bj) { const f32x4 v0 = act4<ACT>(acc[ai][bj][m][0]), v1 = act4<ACT>(acc[ai][bj][m][1]);
                    u32x4 w; w.x = cvt_pk_bf16(v0[0], v0[1]); w.y = cvt_pk_bf16(v0[2], v0[3]); w.z = cvt_pk_bf16(v1[0], v1[1]); w.w = cvt_pk_bf16(v1[2], v1[3]);
                    *(u32x4*)(rowp + bj * HALF) = w; } }
    }
    __device__ __forceinline__ void operator()(const f32x4 (&acc)[2][2][4][2], const Unit& u, int wr, int wc, int fr, int fq) const {
        const int pn = u.pn;
        if (pn < 8) run<1>(acc, u, wr, wc, fr, fq);
        else if (pn < 12 || pn >= 20) run<2>(acc, u, wr, wc, fr, fq);
        else if (pn < 14) run<3>(acc, u, wr, wc, fr, fq);
        else run<0>(acc, u, wr, wc, fr, fq);
    }
};
struct EpiF32 {
    static constexpr bool PERM = false, AFTER_DRAIN = false;
    float* O; int ldc;
    __device__ __forceinline__ void operator()(const f32x4 (&acc)[2][2][4][2], const Unit& u, int wr, int wc, int fr, int fq) const {
        const int row0 = u.pm * BM + wr * 64 + fr, col0 = u.pn * BM + wc * 32 + 4 * fq;
#pragma unroll
        for (int ai = 0; ai < 2; ++ai)
#pragma unroll
            for (int m = 0; m < 4; ++m) { float* rowp = O + (size_t)(row0 + ai * HALF + m * 16) * ldc + col0;
#pragma unroll
                for (int bj = 0; bj < 2; ++bj)
#pragma unroll
                    for (int n = 0; n < 2; ++n) *(f32x4*)(rowp + bj * HALF + n * 16) = acc[ai][bj][m][n]; }
    }
};

template <class Epi, class Sched, bool ALIGN_EPI = false>
__device__ __forceinline__ void gemm_phase(PG8_LAS unsigned char* lds, const Gemm g, const Sched& S, const Epi& E) {
    const int tid = threadIdx.x, wid = __builtin_amdgcn_readfirstlane(tid >> 6), lane = tid & 63, wr = wid >> 2, wc = wid & 3, fr = lane & 15, fq = lane >> 4;
    const int K = g.K, nt = K / BK, lda = g.lda, ksplit = g.ksplit;
    unsigned voffA[2], voffB[2];
#pragma unroll
    for (int i = 0; i < 2; ++i) { int R, C; stage_rc(tid * 16 + i * 8192, R, C); const int Rb = Epi::PERM ? ((R & ~31) + perm32(R & 31)) : R;
        voffA[i] = (unsigned)(R * lda + C) * 2u; voffB[i] = (unsigned)(Rb * K + C) * 2u; }
    const size_t kstep = (size_t)(BK * 2);
    const size_t hstepA = (size_t)HALF * lda * 2, hstepB = (size_t)HALF * K * 2;
    const size_t tstepA = 2 * hstepA, tstepB = 2 * hstepB;
    const unsigned ldsw = (unsigned)wid * 1024u;
    const int aoff = lds_byte(wr * 64 + fr, fq * 8), boff = lds_byte(wc * 32 + fr, fq * 8);
#define PG8_SA(b, h) (((b) * 2 + (h)) * HTB)
#define PG8_SB(b, h) ((4 + (b) * 2 + (h)) * HTB)
#define PG8_STAGE(bufoff, gbase, voff) do { _Pragma("unroll") for (int _i = 0; _i < 2; ++_i) \
        __builtin_amdgcn_global_load_lds((const unsigned*)((const char*)(gbase) + (voff)[_i]), (PG8_LAS unsigned*)(lds + (bufoff) + ldsw + _i * 8192), 16, 0, 0); } while (0)
#define PG8_LDA(dst, b, h) do { _Pragma("unroll") for (int m = 0; m < 4; ++m) _Pragma("unroll") for (int k = 0; k < 2; ++k) dst[m][k] = *(const PG8_LAS bf16x8*)(lds + PG8_SA(b, h) + aoff + m * 2048 + k * 1024); } while (0)
#define PG8_LDB(dst, b, h) do { _Pragma("unroll") for (int n = 0; n < 2; ++n) _Pragma("unroll") for (int k = 0; k < 2; ++k) dst[n][k] = *(const PG8_LAS bf16x8*)(lds + PG8_SB(b, h) + boff + n * 2048 + k * 1024); } while (0)
#define PG8_MMA(ai, bj, At, Bt) do { __builtin_amdgcn_s_setprio(1); _Pragma("unroll") for (int m = 0; m < 4; ++m) _Pragma("unroll") for (int n = 0; n < 2; ++n) _Pragma("unroll") for (int k = 0; k < 2; ++k) \
        acc[ai][bj][m][n] = __builtin_amdgcn_mfma_f32_16x16x32_bf16(Bt[n][k], At[m][k], acc[ai][bj][m][n], 0, 0, 0); __builtin_amdgcn_s_setprio(0); } while (0)
#define PG8_WAIT_V(n) asm volatile("s_waitcnt vmcnt(" #n ")" ::: "memory")
#define PG8_WAIT_L(n) asm volatile("s_waitcnt lgkmcnt(" #n ")" ::: "memory")
#define PG8_BAR __builtin_amdgcn_s_barrier()
#define PG8_SCHED __builtin_amdgcn_sched_barrier(0)
#define PG8_TA(t) (((t) < ksplit ? cA : cA2) + (size_t)(t) * kstep)
    Unit cur, nxt; int ui = 0;
    if (!S.next(0, cur)) return;
    f32x4 acc[2][2][4][2];
#pragma unroll
    for (int a = 0; a < 2; ++a)
#pragma unroll
        for (int b = 0; b < 2; ++b)
#pragma unroll
            for (int m = 0; m < 4; ++m)
#pragma unroll
                for (int n = 0; n < 2; ++n) acc[a][b][m][n] = (f32x4){0.f, 0.f, 0.f, 0.f};
    bf16x8 At[4][2], B0[2][2], B1[2][2];
    const size_t seg2 = (size_t)ksplit * kstep;
    const char* cA = (const char*)g.A + (size_t)cur.pm * tstepA; const char* cA2 = (const char*)g.A2 + (size_t)cur.pm * tstepA - seg2; const char* cB = (const char*)g.Bt + (size_t)cur.pn * tstepB;
    S.a_ready(cur);
    PG8_STAGE(PG8_SB(0, 0), cB, voffB); PG8_STAGE(PG8_SB(0, 1), cB + hstepB, voffB); PG8_STAGE(PG8_SA(0, 0), cA, voffA); PG8_STAGE(PG8_SA(0, 1), cA + hstepA, voffA);
    if (wr == 1) PG8_BAR;
    PG8_WAIT_V(2); PG8_BAR;
    PG8_STAGE(PG8_SB(1, 0), cB + kstep, voffB); PG8_STAGE(PG8_SA(1, 0), cA + kstep, voffA); PG8_STAGE(PG8_SB(1, 1), cB + hstepB + kstep, voffB);
    PG8_WAIT_V(6); PG8_BAR;
    for (;;) {
        const bool has_next = S.next(ui + 1, nxt);
        const char* nA = has_next ? (const char*)g.A + (size_t)nxt.pm * tstepA : cA; const char* nB = has_next ? (const char*)g.Bt + (size_t)nxt.pn * tstepB : cB;
        for (int t = 0; t < nt; t += 2) {
            const bool last = (t == nt - 2);
            const char* a1 = PG8_TA(t + 1);
            const char* a2 = last ? nA : PG8_TA(t + 2); const char* b2 = last ? nB : cB + (size_t)(t + 2) * kstep;
            const char* a3 = last ? nA + kstep : PG8_TA(t + 3); const char* b3 = b2 + kstep;
            if (last && has_next) S.a_ready(nxt);
            PG8_LDB(B0, 0, 0); PG8_LDB(B1, 0, 1); PG8_SCHED; PG8_LDA(At, 0, 0); PG8_STAGE(PG8_SA(1, 1), a1 + hstepA, voffA);
            PG8_WAIT_V(8); PG8_WAIT_L(0); PG8_BAR; PG8_MMA(0, 0, At, B0); PG8_MMA(0, 1, At, B1); PG8_BAR; PG8_SCHED;
            PG8_LDA(At, 0, 1); PG8_STAGE(PG8_SB(0, 0), b2, voffB); PG8_STAGE(PG8_SB(0, 1), b2 + hstepB, voffB); PG8_STAGE(PG8_SA(0, 0), a2, voffA);
            PG8_WAIT_V(8); PG8_WAIT_L(0); PG8_BAR; PG8_MMA(1, 0, At, B0); PG8_MMA(1, 1, At, B1); PG8_BAR; PG8_SCHED;
            PG8_LDB(B0, 1, 0); PG8_LDB(B1, 1, 1); PG8_SCHED; PG8_LDA(At, 1, 0); PG8_STAGE(PG8_SA(0, 1), a2 + hstepA, voffA);
            PG8_WAIT_V(8); PG8_WAIT_L(0); PG8_BAR; PG8_MMA(0, 0, At, B0); PG8_MMA(0, 1, At, B1); PG8_BAR; PG8_SCHED;
            PG8_LDA(At, 1, 1); PG8_STAGE(PG8_SB(1, 0), b3, voffB); PG8_STAGE(PG8_SB(1, 1), b3 + hstepB, voffB); PG8_STAGE(PG8_SA(1, 0), a3, voffA);
            PG8_WAIT_V(8); PG8_WAIT_L(0); PG8_BAR; PG8_MMA(1, 0, At, B0); PG8_MMA(1, 1, At, B1); PG8_BAR; PG8_SCHED;
        }
        if constexpr (ALIGN_EPI) { if (wr == 0) PG8_BAR; }
        if constexpr (!Epi::AFTER_DRAIN) { E(acc, cur, wr, wc, fr, fq); S.done(cur); }
        if (!has_next) break;
#pragma unroll
        for (int a = 0; a < 2; ++a)
#pragma unroll
            for (int b = 0; b < 2; ++b)
#pragma unroll
                for (int m = 0; m < 4; ++m)
#pragma unroll
                    for (int n = 0; n < 2; ++n) acc[a][b][m][n] = (f32x4){0.f, 0.f, 0.f, 0.f};
        cur = nxt; cA = nA; cA2 = (const char*)g.A2 + (size_t)nxt.pm * tstepA - seg2; cB = nB; ++ui;
        if constexpr (ALIGN_EPI) { if (wr == 1) PG8_BAR; }
    }
    PG8_WAIT_V(0);
    if constexpr (!ALIGN_EPI) { if (wr == 0) PG8_BAR; }
    PG8_BAR;
    if constexpr (Epi::AFTER_DRAIN) { E.fused(acc, cur, wr, wc, fr, fq, lds, wid, lane); S.done(cur); }
#undef PG8_SA
#undef PG8_SB
#undef PG8_STAGE
#undef PG8_LDA
#undef PG8_LDB
#undef PG8_MMA
#undef PG8_WAIT_V
#undef PG8_WAIT_L
#undef PG8_BAR
#undef PG8_SCHED
#undef PG8_TA
}
}
#define GAS __attribute__((address_space(1)))
#define LAS __attribute__((address_space(3)))
typedef unsigned short bf16;
typedef unsigned v4u __attribute__((ext_vector_type(4)));
typedef float f32x4 __attribute__((ext_vector_type(4)));
typedef short bf16x8 __attribute__((ext_vector_type(8)));
typedef GAS unsigned gu32;
typedef GAS unsigned long long gu64;
#define RLX_AGENT __ATOMIC_RELAXED, __HIP_MEMORY_SCOPE_AGENT
#define LDS_WAIT() asm volatile("s_waitcnt lgkmcnt(0)" ::: "memory")
#define VM_WAIT() asm volatile("s_waitcnt vmcnt(0)" ::: "memory")
__device__ __forceinline__ unsigned long long rt() { return __builtin_amdgcn_s_memrealtime(); }
__device__ __forceinline__ unsigned f2bf(float f) { unsigned u = __builtin_bit_cast(unsigned, f); return (u + 0x7fffu + ((u >> 16) & 1u)) >> 16; }
__device__ __forceinline__ unsigned pk2(float lo, float hi) { return f2bf(lo) | (f2bf(hi) << 16); }

#define XB_TMO      128
#define XB_XCNT(j)  (256  + 64 * (j))
#define XB_XSUB(j)  (1280 + 64 * (j))
#define XB_XGEN(j)  (2304 + 64 * (j))
#define XB_TOP      3328
#define XB_TOPGEN   3392
#define XCD_BAR_WORDS 3456
#define XB_SPIN_CAP (1u << 18)

__device__ __forceinline__ unsigned xb_ld(unsigned* p)              { return __hip_atomic_load(p, __ATOMIC_RELAXED, __HIP_MEMORY_SCOPE_AGENT); }
__device__ __forceinline__ unsigned xb_add(unsigned* p, unsigned v) { return __hip_atomic_fetch_add(p, v, __ATOMIC_RELAXED, __HIP_MEMORY_SCOPE_AGENT); }
__device__ __forceinline__ unsigned xb_xcc_id() { return (unsigned)__builtin_amdgcn_s_getreg((3 << 11) | 20) & 0xFu; }
#define XB_SPIN(cond, bar) do { unsigned _sp = 0; while (cond) { __builtin_amdgcn_s_sleep(1); \
    if ((++_sp & 255u) == 0u) { if (xb_ld(&(bar)[XB_TMO])) break; if (_sp > XB_SPIN_CAP) { atomicAdd(&(bar)[XB_TMO], 1u); break; } } } } while (0)

struct XcdBarrier {
    unsigned* bar; unsigned x;
    volatile LAS unsigned* st;
};

__device__ __forceinline__ XcdBarrier xcd_barrier_post(unsigned* bar, volatile LAS unsigned* st) {
    XcdBarrier b; b.bar = bar; b.x = xb_xcc_id(); b.st = st;
    if (threadIdx.x == 0) (void)xb_add(&bar[XB_XCNT(b.x)], 1u);
    return b;
}
__device__ __forceinline__ void xcd_barrier_complete(unsigned* bar, unsigned x, unsigned& nloc, unsigned& nx) {
    const unsigned G = gridDim.x * gridDim.y * gridDim.z;
    unsigned sum, cnt, mine, sp = 0u;
    for (;;) {
        sum = 0u; cnt = 0u; mine = 0u;
#pragma unroll
        for (unsigned j = 0; j < 16; ++j) { const unsigned c = xb_ld(&bar[XB_XCNT(j)]); sum += c; cnt += (c > 0u) ? 1u : 0u; mine = (j == x) ? c : mine; }
        if (sum == G) break;
        __builtin_amdgcn_s_sleep(1);
        if ((++sp & 255u) == 0u) { if (xb_ld(&bar[XB_TMO])) break; if (sp > XB_SPIN_CAP) { atomicAdd(&bar[XB_TMO], 1u); break; } }
    }
    nloc = mine > 0u ? mine : 1u; nx = cnt > 0u ? cnt : 1u;
}

__device__ __forceinline__ void xcd_barrier(const XcdBarrier& b) {
    asm volatile("s_waitcnt vmcnt(0)" ::: "memory");
    __syncthreads();
    if (threadIdx.x == 0) {
        unsigned* bar = b.bar;
        __builtin_amdgcn_s_waitcnt(0);
        unsigned nloc = b.st[0], nx = b.st[1];
        if (nloc == 0u) { xcd_barrier_complete(bar, b.x, nloc, nx); b.st[0] = nloc; b.st[1] = nx; }
        const unsigned old = xb_add(&bar[XB_XSUB(b.x)], 1u);
        const unsigned gen = old / nloc;
        if (old + 1u == (gen + 1u) * nloc) {
            __builtin_amdgcn_fence(__ATOMIC_RELEASE, "agent");
            asm volatile("s_waitcnt vmcnt(0)" ::: "memory");
            const unsigned og = xb_add(&bar[XB_TOP], 1u);
            const unsigned tg = og / nx;
            if (og + 1u == (tg + 1u) * nx) xb_add(&bar[XB_TOPGEN], 1u);
            else XB_SPIN(xb_ld(&bar[XB_TOPGEN]) == tg, bar);
            __builtin_amdgcn_fence(__ATOMIC_ACQUIRE, "agent");
            xb_add(&bar[XB_XGEN(b.x)], 1u);
            asm volatile("s_waitcnt vmcnt(0)" ::: "memory");
        } else {
            XB_SPIN(xb_ld(&bar[XB_XGEN(b.x)]) == gen, bar);
            __builtin_amdgcn_fence(__ATOMIC_ACQUIRE, "agent");
            asm volatile("s_waitcnt vmcnt(0)" ::: "memory");
        }
    }
    __syncthreads();
}

constexpr int NWAVES = 8;
constexpr int BATCH = 8, SEQ = 2048, DM = 1024, M = BATCH * SEQ;
constexpr int D_A = 1024, D_B = 1024, DMIX = 2048, NG = 8, GD = 128, ACH = 128, NH = 4, DK = 128, DV = 256, RANK = 16, BCH = 64;
constexpr int D_IN = 6160, NZ = 6144;
constexpr int ZU = 0, ZV = 1024, ZGA = 2048, ZQ = 3072, ZK = 3584, ZVB = 4096, ZGB = 5120;
constexpr float EPS = 1e-6f;
#ifndef MK_N_LAUNCHES
#define MK_N_LAUNCHES 1
#endif
constexpr int NPH = 6;
constexpr int N_LAUNCHES = MK_N_LAUNCHES;

constexpr size_t MiB = 1u << 20;
constexpr size_t WS_CTL = 0, CTL_ZERO_BYTES = 1 * MiB;
constexpr size_t WS_WIN = 1 * MiB;
constexpr size_t WS_WOUT = 13 * MiB;
constexpr size_t WS_WS = 17 * MiB;
constexpr size_t WS_LR = 18 * MiB;
constexpr size_t WS_SSP = 19 * MiB;
constexpr size_t WS_H = 24 * MiB;
constexpr size_t WS_Z = 56 * MiB;
constexpr size_t WS_END = 248 * MiB;
constexpr int CW_TMO = 0, CW_CODE = 1, CW_BAR = 4096;

constexpr int RING_OFF = 0, RING_BYTES = 131072;
constexpr int LDSCTL_OFF = RING_BYTES, MISC_OFF = LDSCTL_OFF + 320;
constexpr int LDS_BYTES = 147456;

__device__ __forceinline__ float wave_sum(float v) {
#pragma unroll
    for (int o = 1; o < 64; o <<= 1) v += __shfl_xor(v, o);
    return v;
}
__device__ __forceinline__ float bf2f(unsigned short b) { return __builtin_bit_cast(float, (unsigned)b << 16); }
__device__ __forceinline__ float bflo(unsigned w) { return __builtin_bit_cast(float, w << 16); }
__device__ __forceinline__ float bfhi(unsigned w) { return __builtin_bit_cast(float, w & 0xffff0000u); }
__device__ __forceinline__ f32x4 mfma16(bf16x8 a, bf16x8 b, f32x4 c) { return __builtin_amdgcn_mfma_f32_16x16x32_bf16(a, b, c, 0, 0, 0); }
__device__ __forceinline__ bf16x8 ldfrag(const LAS bf16* X, int pitch, int row0, int k0, int fr, int fq) { return *(const LAS bf16x8*)(X + (row0 + fr) * pitch + k0 + 8 * fq); }

__device__ __forceinline__ void p0_transpose_item(const float* W, int K, int ldw, int nblk, bf16* WT, LAS float* scr, int item, int lane) {
    const int kb = item / nblk, nb = item % nblk, k0 = 64 * kb, n0 = 32 * nb;
#pragma unroll 8
    for (int i = 0; i < 32; ++i) { const int kk = 2 * i + (lane >> 5); scr[kk * 33 + (lane & 31)] = W[(size_t)(k0 + kk) * ldw + n0 + (lane & 31)]; }
    LDS_WAIT(); asm volatile("" ::: "memory");
    const int c = lane & 7;
#pragma unroll
    for (int j = 0; j < 4; ++j) { const int n = (lane >> 3) + 8 * j; const LAS float* s = scr + (8 * c) * 33 + n;
        v4u o; o.x = pk2(s[0 * 33], s[1 * 33]); o.y = pk2(s[2 * 33], s[3 * 33]); o.z = pk2(s[4 * 33], s[5 * 33]); o.w = pk2(s[6 * 33], s[7 * 33]);
        *(GAS v4u*)(WT + (size_t)(n0 + n) * K + k0 + 8 * c) = o; }
    LDS_WAIT(); asm volatile("" ::: "memory");
}
__device__ __forceinline__ void p0_row(const float* xrow, const float* g, bf16* hrow, float* lrrow, const LAS float* wT, int lane) {
    const GAS f32x4* xr = (const GAS f32x4*)xrow + lane; const GAS f32x4* gr = (const GAS f32x4*)g + lane;
    f32x4 v[4]; float s = 0.f;
#pragma unroll
    for (int j = 0; j < 4; ++j) { v[j] = xr[64 * j]; s += (v[j].x * v[j].x + v[j].y * v[j].y) + (v[j].z * v[j].z + v[j].w * v[j].w); }
    const float rs = 1.0f / sqrtf(wave_sum(s) * (1.f / DM) + EPS);
#pragma unroll
    for (int j = 0; j < 4; ++j) { const f32x4 gg = gr[64 * j]; v[j] = v[j] * rs * gg; }
    GAS unsigned long long* o8 = (GAS unsigned long long*)hrow + lane;
#pragma unroll
    for (int j = 0; j < 4; ++j) o8[64 * j] = (unsigned long long)pk2(v[j].x, v[j].y) | ((unsigned long long)pk2(v[j].z, v[j].w) << 32);
    float p[16];
#pragma unroll
    for (int r = 0; r < 16; ++r) { float a = 0.f;
#pragma unroll
        for (int j = 0; j < 4; ++j) { const f32x4 w = *(const LAS f32x4*)(wT + r * 1024 + 256 * j + 4 * lane); a += (v[j].x * w.x + v[j].y * w.y) + (v[j].z * w.z + v[j].w * w.w); }
        p[r] = a; if ((r & 3) == 3) asm volatile("" ::: "memory"); }
    float q8[8], q4[4], q2[2], q1;
    { const bool hi = lane & 1;
#pragma unroll
      for (int i = 0; i < 8; ++i) { const float keep = hi ? p[2 * i + 1] : p[2 * i], send = hi ? p[2 * i] : p[2 * i + 1]; q8[i] = keep + __shfl_xor(send, 1); } }
    { const bool hi = lane & 2;
#pragma unroll
      for (int i = 0; i < 4; ++i) { const float keep = hi ? q8[2 * i + 1] : q8[2 * i], send = hi ? q8[2 * i] : q8[2 * i + 1]; q4[i] = keep + __shfl_xor(send, 2); } }
    { const bool hi = lane & 4;
#pragma unroll
      for (int i = 0; i < 2; ++i) { const float keep = hi ? q4[2 * i + 1] : q4[2 * i], send = hi ? q4[2 * i] : q4[2 * i + 1]; q2[i] = keep + __shfl_xor(send, 4); } }
    { const bool hi = lane & 8; const float keep = hi ? q2[1] : q2[0], send = hi ? q2[0] : q2[1]; q1 = keep + __shfl_xor(send, 8); }
    q1 += __shfl_xor(q1, 16); q1 += __shfl_xor(q1, 32);
    if (lane < 16) lrrow[lane] = q1;
}
__device__ __forceinline__ void p0_prologue(const float* x, const float* pre_g, const float* w_in, const float* w_out, const float* a_w_s,
                                            bf16* WinT, bf16* WoutT, bf16* WSm, bf16* H, float* LR, LAS unsigned char* lds, int vcu, int G, int tid, int wave, int lane) {
    LAS float* scr = (LAS float*)(lds + RING_OFF + wave * 16384);
    const int gw = vcu * NWAVES + wave, NGW = G * NWAVES;
    constexpr int I_IN = (DM / 64) * (NZ / 32), I_OUT = (DMIX / 64) * (DM / 32);
    for (int it = gw; it < I_IN + I_OUT; it += NGW) {
        if (it < I_IN) p0_transpose_item(w_in, DM, D_IN, NZ / 32, WinT, scr, it, lane);
        else p0_transpose_item(w_out, DMIX, DM, DM / 32, WoutT, scr, it - I_IN, lane);
    }
    for (int i = vcu * 512 + tid; i < NG * ACH * ACH; i += G * 512) { const int t = (i >> 7) & 127, s = i & 127; WSm[i] = (bf16)f2bf(s <= t ? a_w_s[i] : 0.f); }
    __syncthreads();
    LAS float* wT = (LAS float*)(lds + RING_OFF);
    for (int i = tid; i < 16 * 1024; i += 512) { const int k = i >> 4, r = i & 15; wT[r * 1024 + k] = w_in[(size_t)k * D_IN + NZ + r]; }
    __syncthreads();
    for (int m = gw; m < M; m += NGW) p0_row(x + (size_t)m * DM, pre_g, H + (size_t)m * DM, LR + (size_t)m * 16, wT, lane);
    __syncthreads();
}

constexpr int SG_P = 136;
__device__ __forceinline__ void sgu_phase(bf16* Z, const bf16* WSm, const float* ln_g, const float* ln_b, const float* b_s, LAS unsigned char* lds, int vcu, int G, int tid, int wave, int lane) {
    LAS bf16* vnT = (LAS bf16*)(lds);
    LAS bf16* Wl = (LAS bf16*)(lds + 128 * SG_P * 2);
    LAS float* st = (LAS float*)(lds + 2 * 128 * SG_P * 2);
    const int fr = lane & 15, fq = lane >> 4;
    for (int unit = vcu; unit < 256; unit += G) {
        const int cb = unit >> 1, half = unit & 1, R0 = cb * ACH;
        for (int rr = 0; rr < 16; ++rr) { const int row = wave * 16 + rr; const bf16* vp = Z + (size_t)(R0 + row) * NZ + ZV;
            const v4u a = *(const GAS v4u*)(vp + 8 * lane), b = *(const GAS v4u*)(vp + 512 + 8 * lane);
            float s = 0.f, q = 0.f;
#pragma unroll
            for (int e = 0; e < 4; ++e) { const float x0 = bflo(a[e]), x1 = bfhi(a[e]), x2 = bflo(b[e]), x3 = bfhi(b[e]); s += (x0 + x1) + (x2 + x3); q += (x0 * x0 + x1 * x1) + (x2 * x2 + x3 * x3); }
            s = wave_sum(s); q = wave_sum(q);
            const float mean = s * (1.f / D_A); float var = q * (1.f / D_A) - mean * mean; var = var > 0.f ? var : 0.f;
            if (lane == 0) { st[2 * row] = mean; st[2 * row + 1] = 1.0f / sqrtf(var + EPS); } }
        __syncthreads();
        for (int gi = 0; gi < 4; ++gi) { const int g = half * 4 + gi;
#pragma unroll
            for (int it = 0; it < 4; ++it) { const int idx = tid + 512 * it, r = idx >> 4, cblk = idx & 15;
                *(LAS v4u*)(Wl + r * SG_P + 8 * cblk) = *(const GAS v4u*)(WSm + (size_t)g * ACH * ACH + r * 128 + 8 * cblk);
                const v4u vv = *(const GAS v4u*)(Z + (size_t)(R0 + r) * NZ + ZV + g * GD + 8 * cblk);
                const float mean = st[2 * r], rstd = st[2 * r + 1]; const int c0 = 8 * cblk;
                const f32x4 g0 = *(const GAS f32x4*)(ln_g + g * GD + c0), g1 = *(const GAS f32x4*)(ln_g + g * GD + c0 + 4), b0 = *(const GAS f32x4*)(ln_b + g * GD + c0), b1 = *(const GAS f32x4*)(ln_b + g * GD + c0 + 4);
                float xn[8];
#pragma unroll
                for (int e = 0; e < 4; ++e) { xn[2 * e] = bflo(vv[e]); xn[2 * e + 1] = bfhi(vv[e]); }
#pragma unroll
                for (int e = 0; e < 8; ++e) { const float gg = e < 4 ? g0[e & 3] : g1[e & 3], bb = e < 4 ? b0[e & 3] : b1[e & 3]; vnT[(c0 + e) * SG_P + r] = (bf16)f2bf((xn[e] - mean) * rstd * gg + bb); } }
            __syncthreads();
            f32x4 acc[8];
#pragma unroll
            for (int tt = 0; tt < 8; ++tt) acc[tt] = (f32x4){0.f, 0.f, 0.f, 0.f};
#pragma unroll
            for (int ks = 0; ks < 4; ++ks) { const bf16x8 a = ldfrag(vnT, SG_P, 16 * wave, 32 * ks, fr, fq);
#pragma unroll
                for (int tt = 0; tt < 8; ++tt) acc[tt] = mfma16(a, ldfrag(Wl, SG_P, 16 * tt, 32 * ks, fr, fq), acc[tt]); }
#pragma unroll
            for (int tt = 0; tt < 8; ++tt) { const int t = 16 * tt + fr; const size_t off = (size_t)(R0 + t) * NZ + g * GD + 16 * wave + 4 * fq;
                const pg8::u32x2 uu = *(const GAS pg8::u32x2*)(Z + off + ZU), gg = *(const GAS pg8::u32x2*)(Z + off + ZGA); const float bs = b_s[g * ACH + t];
                const float o0 = bflo(uu.x) * (acc[tt][0] + bs) * bflo(gg.x), o1 = bfhi(uu.x) * (acc[tt][1] + bs) * bfhi(gg.x), o2 = bflo(uu.y) * (acc[tt][2] + bs) * bflo(gg.y), o3 = bfhi(uu.y) * (acc[tt][3] + bs) * bfhi(gg.y);
                pg8::u32x2 w; w.x = pk2(o0, o1); w.y = pk2(o2, o3); *(GAS pg8::u32x2*)(Z + off + ZU) = w; }
            __syncthreads();
        }
    }
}

constexpr int GL_P = 136, GL_PJ = 72;
__device__ __forceinline__ float logsigmoid_f(float x) { return fminf(x, 0.f) - log1pf(expf(-fabsf(x))); }
__device__ __forceinline__ void gla_phase(bf16* Z, const float* LR, const float* w_a2, const float* b_a2, const float* gn, float* SSP, LAS unsigned char* lds, int vcu, int G, int tid, int wave, int lane) {
    LAS bf16* QE = (LAS bf16*)(lds);
    LAS bf16* KE = QE + 64 * GL_P;
    LAS bf16* QB = KE + 64 * GL_P;
    LAS bf16* KDT = QB + 64 * GL_P;
    LAS bf16* VT = KDT + 128 * GL_PJ;
    LAS bf16* P = VT + 32 * GL_PJ;
    LAS bf16* SbT = P + 64 * GL_PJ;
    LAS float* LRs = (LAS float*)(SbT + 32 * GL_P);
    LAS float* tot = LRs + 64 * 16;
    LAS float* dec = tot + 4 * 128;
    const int fr = lane & 15, fq = lane >> 4;
    for (int unit = vcu; unit < 256; unit += G) {
        const int bh = unit >> 3, dvs = unit & 7, b = bh >> 2, h = bh & 3;
        const int d = tid & 127, iq = tid >> 7;
        float wa[16];
#pragma unroll
        for (int r = 0; r < 16; ++r) wa[r] = w_a2[r * 512 + h * DK + d];
        const float ba = b_a2[h * DK + d];
        f32x4 S[2] = {(f32x4){0.f, 0.f, 0.f, 0.f}, (f32x4){0.f, 0.f, 0.f, 0.f}};
        for (int i = tid; i < 32 * GL_P / 2; i += 512) ((LAS unsigned*)SbT)[i] = 0u;
        __syncthreads();
        for (int n = 0; n < SEQ / BCH; ++n) {
            const int R0 = b * SEQ + n * BCH;
            if (tid < 256) *(LAS f32x4*)(LRs + 4 * tid) = *(const GAS f32x4*)(LR + (size_t)R0 * 16 + 4 * tid);
            { const int v = tid & 31, jq = tid >> 5; const bf16* vp = Z + (size_t)(R0 + 4 * jq) * NZ + ZVB + h * DV + dvs * 32 + v;
              const unsigned e0 = vp[0], e1 = vp[NZ], e2 = vp[2 * NZ], e3 = vp[3 * NZ];
              pg8::u32x2 w; w.x = e0 | (e1 << 16); w.y = e2 | (e3 << 16); *(LAS pg8::u32x2*)(VT + v * GL_PJ + 4 * jq) = w; }
            __syncthreads();
            float c[16]; float run = 0.f;
#pragma unroll
            for (int ii = 0; ii < 16; ++ii) { const int i = 16 * iq + ii; float gl = ba;
#pragma unroll
                for (int r4 = 0; r4 < 4; ++r4) { const f32x4 l4 = *(const LAS f32x4*)(LRs + i * 16 + 4 * r4); gl += (l4.x * wa[4 * r4] + l4.y * wa[4 * r4 + 1]) + (l4.z * wa[4 * r4 + 2] + l4.w * wa[4 * r4 + 3]); }
                run += logsigmoid_f(gl) * (1.0f / 16.0f); c[ii] = run; }
            tot[iq * 128 + d] = run;
            __syncthreads();
            const float t0 = tot[d], t1 = tot[128 + d], t2 = tot[256 + d], t3 = tot[384 + d];
            const float off = (iq > 0 ? t0 : 0.f) + (iq > 1 ? t1 : 0.f) + (iq > 2 ? t2 : 0.f), bref = t0 + t1, blast = (t0 + t1) + (t2 + t3);
            unsigned kdp[8];
#pragma unroll
            for (int ii = 0; ii < 16; ++ii) { const int i = 16 * iq + ii; const float bb = c[ii] + off;
                const float q = bf2f(Z[(size_t)(R0 + i) * NZ + ZQ + h * DK + d]), k = bf2f(Z[(size_t)(R0 + i) * NZ + ZK + h * DK + d]);
                QE[i * GL_P + d] = (bf16)f2bf(q * expf(bb - bref)); KE[i * GL_P + d] = (bf16)f2bf(k * expf(bref - bb)); QB[i * GL_P + d] = (bf16)f2bf(q * expf(bb));
                const unsigned kd = f2bf(k * expf(blast - bb)); if (ii & 1) kdp[ii >> 1] |= kd << 16; else kdp[ii >> 1] = kd; }
            *(LAS v4u*)(KDT + d * GL_PJ + 16 * iq) = (v4u){kdp[0], kdp[1], kdp[2], kdp[3]}; *(LAS v4u*)(KDT + d * GL_PJ + 16 * iq + 8) = (v4u){kdp[4], kdp[5], kdp[6], kdp[7]};
            if (iq == 0) dec[d] = expf(blast);
            __syncthreads();
            { const int it = wave >> 1;
#pragma unroll
              for (int jj = 0; jj < 2; ++jj) { const int jt = 2 * (wave & 1) + jj; f32x4 a = (f32x4){0.f, 0.f, 0.f, 0.f};
#pragma unroll
                for (int ks = 0; ks < 4; ++ks) a = mfma16(ldfrag(KE, GL_P, 16 * jt, 32 * ks, fr, fq), ldfrag(QE, GL_P, 16 * it, 32 * ks, fr, fq), a);
                const int i = 16 * it + fr, j0 = 16 * jt + 4 * fq;
                pg8::u32x2 w; w.x = pk2(j0 <= i ? a[0] : 0.f, j0 + 1 <= i ? a[1] : 0.f); w.y = pk2(j0 + 2 <= i ? a[2] : 0.f, j0 + 3 <= i ? a[3] : 0.f);
                *(LAS pg8::u32x2*)(P + i * GL_PJ + j0) = w; } }
            __syncthreads();
            { const int it = wave >> 1, vt = wave & 1; f32x4 o4 = (f32x4){0.f, 0.f, 0.f, 0.f};
#pragma unroll
              for (int ks = 0; ks < 2; ++ks) o4 = mfma16(ldfrag(VT, GL_PJ, 16 * vt, 32 * ks, fr, fq), ldfrag(P, GL_PJ, 16 * it, 32 * ks, fr, fq), o4);
#pragma unroll
              for (int ks = 0; ks < 4; ++ks) o4 = mfma16(ldfrag(SbT, GL_P, 16 * vt, 32 * ks, fr, fq), ldfrag(QB, GL_P, 16 * it, 32 * ks, fr, fq), o4);
              float ss = (o4[0] * o4[0] + o4[1] * o4[1]) + (o4[2] * o4[2] + o4[3] * o4[3]); ss += __shfl_xor(ss, 16); ss += __shfl_xor(ss, 32);
              const int row = R0 + 16 * it + fr, col = h * DV + dvs * 32 + 16 * vt + 4 * fq;
              if (fq == 0) SSP[(size_t)row * 64 + h * 16 + dvs * 2 + vt] = ss;
              bf16* gp = Z + (size_t)row * NZ + ZGB + col; const pg8::u32x2 gg = *(const GAS pg8::u32x2*)gp; const f32x4 g4 = *(const GAS f32x4*)(gn + col);
              pg8::u32x2 w; w.x = pk2(o4[0] * g4.x * bflo(gg.x), o4[1] * g4.y * bfhi(gg.x)); w.y = pk2(o4[2] * g4.z * bflo(gg.y), o4[3] * g4.w * bfhi(gg.y));
              *(GAS pg8::u32x2*)gp = w; }
            { const f32x4 d4 = *(const LAS f32x4*)(dec + 16 * wave + 4 * fq);
#pragma unroll
              for (int vt = 0; vt < 2; ++vt) { S[vt] = S[vt] * d4;
#pragma unroll
                for (int ks = 0; ks < 2; ++ks) S[vt] = mfma16(ldfrag(KDT, GL_PJ, 16 * wave, 32 * ks, fr, fq), ldfrag(VT, GL_PJ, 16 * vt, 32 * ks, fr, fq), S[vt]); } }
            __syncthreads();
#pragma unroll
            for (int vt = 0; vt < 2; ++vt) { pg8::u32x2 w; w.x = pk2(S[vt][0], S[vt][1]); w.y = pk2(S[vt][2], S[vt][3]); *(LAS pg8::u32x2*)(SbT + (16 * vt + fr) * GL_P + 16 * wave + 4 * fq) = w; }
        }
        __syncthreads();
    }
}

__device__ __forceinline__ void bnorm_phase(bf16* Z, const float* SSP, int vcu, int G, int wave, int lane) {
    const int gw = vcu * NWAVES + wave, NGW = G * NWAVES;
    for (int m = gw; m < M; m += NGW) {
        const int h = lane >> 4; const float* sp = SSP + (size_t)m * 64 + h * 16; float ss = 0.f;
#pragma unroll
        for (int e = 0; e < 4; ++e) { const f32x4 p = *(const GAS f32x4*)(sp + 4 * e); ss += (p.x + p.y) + (p.z + p.w); }
        const float rs = 1.0f / sqrtf(ss * (1.f / DV) + EPS);
        bf16* zp = Z + (size_t)m * NZ + ZGB + 16 * lane;
#pragma unroll
        for (int e = 0; e < 2; ++e) { const v4u a = *(const GAS v4u*)(zp + 8 * e); v4u o;
#pragma unroll
            for (int k = 0; k < 4; ++k) o[k] = pk2(bflo(a[k]) * rs, bfhi(a[k]) * rs);
            *(GAS v4u*)(zp + 8 * e) = o; }
    }
}

__device__ __forceinline__ void final_phase(const float* x, const float* post_g, float* out, int vcu, int G, int wave, int lane) {
    const int gw = vcu * NWAVES + wave, NGW = G * NWAVES;
    for (int m = gw; m < M; m += NGW) {
        GAS f32x4* yr = (GAS f32x4*)(out + (size_t)m * DM) + lane; const GAS f32x4* xr = (const GAS f32x4*)(x + (size_t)m * DM) + lane; const GAS f32x4* gr = (const GAS f32x4*)post_g + lane;
        f32x4 v[4]; float s = 0.f;
#pragma unroll
        for (int j = 0; j < 4; ++j) { v[j] = yr[64 * j]; s += (v[j].x * v[j].x + v[j].y * v[j].y) + (v[j].z * v[j].z + v[j].w * v[j].w); }
        const float rs = 1.0f / sqrtf(wave_sum(s) * (1.f / DM) + EPS);
#pragma unroll
        for (int j = 0; j < 4; ++j) yr[64 * j] = xr[64 * j] + v[j] * rs * gr[64 * j];
    }
}

struct Args { const float* in[12]; float* out; unsigned char* ws; int ph_lo, ph_hi, li, pad; };
__global__ void __launch_bounds__(NWAVES * 64, 2) hyb_fwd(Args args) {
    extern __shared__ __attribute__((aligned(16))) unsigned char lds_raw[];
    LAS unsigned char* lds = (LAS unsigned char*)lds_raw;
    volatile LAS unsigned* MISC = (volatile LAS unsigned*)(lds + MISC_OFF);
    const int tid = threadIdx.x, lane = tid & 63, wave = __builtin_amdgcn_readfirstlane(tid >> 6);
    const int G = gridDim.x; const int bx = blockIdx.x; const int vcu = (G % 8 == 0) ? (bx % 8) * (G / 8) + bx / 8 : bx;
    unsigned char* ws = args.ws;
    gu32* ctl = (gu32*)(ws + WS_CTL);
    const float* x = args.in[0]; const float* pre_g = args.in[1]; const float* w_in = args.in[2]; const float* w_a2 = args.in[3]; const float* b_a2 = args.in[4];
    const float* ln_g = args.in[5]; const float* ln_b = args.in[6]; const float* a_w_s = args.in[7]; const float* a_b_s = args.in[8]; const float* bn_g = args.in[9];
    const float* w_out = args.in[10]; const float* post_g = args.in[11];
    bf16* WinT = (bf16*)(ws + WS_WIN); bf16* WoutT = (bf16*)(ws + WS_WOUT); bf16* WSm = (bf16*)(ws + WS_WS); float* LR = (float*)(ws + WS_LR); float* SSP = (float*)(ws + WS_SSP);
    bf16* H = (bf16*)(ws + WS_H); bf16* Z = (bf16*)(ws + WS_Z);
    for (int u = tid; u < (LDS_BYTES - LDSCTL_OFF) / 4; u += NWAVES * 64) ((LAS unsigned*)(lds + LDSCTL_OFF))[u] = 0u;
    __syncthreads();
    XcdBarrier bar; bar.bar = (unsigned*)(ctl + CW_BAR); bar.x = 0; bar.st = nullptr;
    if (N_LAUNCHES == 1) bar = xcd_barrier_post((unsigned*)(ctl + CW_BAR), MISC + 8);
#define GRID_BAR() do { if (N_LAUNCHES == 1) xcd_barrier(bar); } while (0)
    const int lo = args.ph_lo, hi = args.ph_hi;
#define IN(k) (lo <= (k) && (k) < hi)
    if (IN(0)) { p0_prologue(x, pre_g, w_in, w_out, a_w_s, WinT, WoutT, WSm, H, LR, lds, vcu, G, tid, wave, lane); GRID_BAR(); }
    if (IN(1)) { pg8::Gemm g{H, H, WinT, M, NZ, DM, DM, DM / 64}; pg8::StaticOrder S; S.init(M, NZ, G, bx);
        pg8::EpiZ E{Z, NZ};
        pg8::gemm_phase<pg8::EpiZ, pg8::StaticOrder, true>(lds + RING_OFF, g, S, E); GRID_BAR(); }
    if (IN(2)) { gla_phase(Z, LR, w_a2, b_a2, bn_g, SSP, lds, vcu, G, tid, wave, lane);
        sgu_phase(Z, WSm, ln_g, ln_b, a_b_s, lds, vcu, G, tid, wave, lane); GRID_BAR(); }
    if (IN(3)) { bnorm_phase(Z, SSP, vcu, G, wave, lane); GRID_BAR(); }
    if (IN(4)) { pg8::Gemm g{Z + ZU, Z + ZGB, WoutT, M, DM, DMIX, NZ, D_A / 64}; pg8::StaticOrder S; S.init(M, DM, G, bx);
        pg8::EpiF32 E{args.out, DM};
        pg8::gemm_phase<pg8::EpiF32, pg8::StaticOrder, false>(lds + RING_OFF, g, S, E); GRID_BAR(); }
    if (IN(5)) { final_phase(x, post_g, args.out, vcu, G, wave, lane); }
#undef IN
#undef GRID_BAR
}

extern "C" void kernel_launch(void* const* d_in, const int* in_sizes, int n_in, void* d_out, int out_size, void* d_ws, size_t ws_size, hipStream_t stream) {
    static int grid = 0;
    if (grid == 0) {
        if (n_in != 12 || in_sizes[0] != M * DM || out_size != M * DM || ws_size < WS_END) { fprintf(stderr, "kernel_launch: unexpected shapes (n_in %d, in0 %d, out %d, ws %zu); nothing launched\n", n_in, n_in > 0 ? in_sizes[0] : -1, out_size, ws_size); grid = -1; return; }
        int dev = 0, cus = 0, per_cu = 0;
        if (hipGetDevice(&dev) != hipSuccess || hipDeviceGetAttribute(&cus, hipDeviceAttributeMultiprocessorCount, dev) != hipSuccess) { fprintf(stderr, "kernel_launch: device query failed\n"); grid = -1; return; }
        if (hipFuncSetAttribute((const void*)hyb_fwd, hipFuncAttributeMaxDynamicSharedMemorySize, LDS_BYTES) != hipSuccess) { fprintf(stderr, "kernel_launch: hipFuncSetAttribute failed\n"); grid = -1; return; }
        if (hipOccupancyMaxActiveBlocksPerMultiprocessor(&per_cu, (const void*)hyb_fwd, NWAVES * 64, LDS_BYTES) != hipSuccess || per_cu < 1)
            fprintf(stderr, "kernel_launch: note: occupancy query reports %d workgroups per CU\n", per_cu);
        (void)hipGetLastError();
        grid = cus;
    }
    if (grid < 0) return;
    if (hipMemsetAsync((char*)d_ws + WS_CTL, 0, CTL_ZERO_BYTES, stream) != hipSuccess) { fprintf(stderr, "kernel_launch: hipMemsetAsync failed\n"); return; }
    Args a{};
    for (int i = 0; i < 12; ++i) a.in[i] = (const float*)d_in[i];
    a.out = (float*)d_out; a.ws = (unsigned char*)d_ws;
    for (int li = 0; li < N_LAUNCHES; ++li) {
        a.ph_lo = (N_LAUNCHES == 1) ? 0 : li; a.ph_hi = (N_LAUNCHES == 1) ? NPH : li + 1; a.li = li;
        hipLaunchKernelGGL(hyb_fwd, dim3(grid), dim3(NWAVES * 64), LDS_BYTES, stream, a);
        const hipError_t le = hipPeekAtLastError();
        if (le != hipSuccess) { fprintf(stderr, "kernel_launch: launch %d failed: %s\n", li, hipGetErrorName(le)); break; }
    }
}
```

```cpp
#include <hip/hip_runtime.h>
#include <cstdio>
#include <cstdint>
namespace pg8 {
#define PG8_LAS __attribute__((address_space(3)))
typedef unsigned short bf16_t;
typedef short bf16x8 __attribute__((ext_vector_type(8)));
typedef float f32x4 __attribute__((ext_vector_type(4)));
typedef float f32x2 __attribute__((ext_vector_type(2)));
typedef unsigned u32x4 __attribute__((ext_vector_type(4)));
typedef unsigned u32x2 __attribute__((ext_vector_type(2)));
constexpr int BM = 256, BK = 64, HALF = 128, HTB = HALF * BK * 2  , STAGE_BYTES = 8 * HTB, NXCD = 8, WGM = 8;

__host__ __device__ __forceinline__ int lds_byte(int r, int c) { const int st = (r >> 4) * 2 + (c >> 5), rr = r & 15, cc = c & 31, ob = rr * 64 + cc * 2; return st * 1024 + (ob ^ (((ob >> 9) & 1) << 5)); }
__host__ __device__ __forceinline__ void stage_rc(int b, int& R, int& C) { const int st = b / 1024, sb = b % 1024, swz = sb ^ (((sb >> 9) & 1) << 5); R = (st >> 1) * 16 + swz / 64; C = (st & 1) * 32 + (swz % 64) / 2; }
__host__ __device__ __forceinline__ int perm32(int rho) { const int n = rho >> 4, i = rho & 15; return 8 * (i >> 2) + 4 * n + (i & 3); }

struct Unit { int pm, pn; };
struct Gemm { const bf16_t* A; const bf16_t* A2; const bf16_t* Bt; int M, N, K, lda, ksplit; };

struct StaticOrder {
    int nM, nN, nwg, G, c;
    __host__ __device__ void init(int M, int N, int G_, int c_) { nM = M / BM; nN = N / BM; nwg = nM * nN; G = G_; c = c_; }
    __host__ __device__ bool next(int i, Unit& u) const {
        const long L = (long)i * G + c; if (L >= nwg) return false;
        int wgid = (int)L; { const int q = nwg / NXCD, r = nwg % NXCD, xcd = wgid % NXCD, off = wgid / NXCD; wgid = (xcd < r ? xcd * (q + 1) : r * (q + 1) + (xcd - r) * q) + off; }
        const int nig = WGM * nN, gid = wgid / nig, fm = gid * WGM, gsz = (nM - fm) < WGM ? (nM - fm) : WGM;
        u.pm = fm + ((wgid % nig) % gsz); u.pn = (wgid % nig) / gsz; return true;
    }
    __device__ __forceinline__ void a_ready(const Unit&) const {}
    __device__ __forceinline__ void done(const Unit&) const {}
};

__device__ __forceinline__ unsigned cvt_pk_bf16(float lo, float hi) { unsigned r; asm volatile("v_cvt_pk_bf16_f32 %0, %1, %2" : "=v"(r) : "v"(lo), "v"(hi)); return r; }
__device__ __forceinline__ f32x2 gelu_pk(f32x2 v) {
    const f32x2 av = __builtin_elementwise_abs(v), d = av * 0.2316418882f + 1.0f;
    f32x2 t; t.x = __builtin_amdgcn_rcpf(d.x); t.y = __builtin_amdgcn_rcpf(d.y);
    f32x2 q = t * 0.5307027145f + (-0.7265760135f); q = q * t + 0.7107068705f; q = q * t + (-0.142248368f); q = q * t + 0.127414796f; q = q * t;
    const f32x2 s = (v * v) * (-0.72134752044f);
    f32x2 e; e.x = __builtin_amdgcn_exp2f(s.x); e.y = __builtin_amdgcn_exp2f(s.y);
    const f32x2 m = v * (q * e), r = v - m;
    f32x2 o; o.x = v.x < 0.f ? m.x : r.x; o.y = v.y < 0.f ? m.y : r.y; return o;
}
__device__ __forceinline__ float silu_f(float x) { return x * __builtin_amdgcn_rcpf(1.0f + __builtin_amdgcn_exp2f(x * -1.4426950408889634f)); }
template <int ACT> __device__ __forceinline__ f32x4 act4(f32x4 v) {
    if (ACT == 1) { f32x2 a = gelu_pk((f32x2){v[0], v[1]}), b = gelu_pk((f32x2){v[2], v[3]}); return (f32x4){a.x, a.y, b.x, b.y}; }
    if (ACT == 2) { return (f32x4){silu_f(v[0]), silu_f(v[1]), silu_f(v[2]), silu_f(v[3])}; }
    if (ACT == 3) { return v * 0.08838834764831845f; }
    return v;
}

struct EpiZ {
    static constexpr bool PERM = true, AFTER_DRAIN = false;
    bf16_t* Z; int ldc;
    template <int ACT> __device__ __forceinline__ void run(const f32x4 (&acc)[2][2][4][2], const Unit& u, int wr, int wc, int fr, int fq) const {
        const int row0 = u.pm * BM + wr * 64 + fr, col0 = u.pn * BM + wc * 32 + 8 * fq;
#pragma unroll
        for (int ai = 0; ai < 2; ++ai)
#pragma unroll
            for (int m = 0; m < 4; ++m) { bf16_t* rowp = Z + (size_t)(row0 + ai * HALF + m * 16) * ldc + col0;
#pragma unroll
                for (int bj = 0; bj < 2; ++bj) { const f32x4 v0 = act4<ACT>(acc[ai][bj][m][0]), v1 = act4<ACT>(acc[ai][bj][m][1]);
                    u32x4 w; w.x = cvt_pk_bf16(v0[0], v0[1]); w.y = cvt_pk_bf16(v0[2], v0[3]); w.z = cvt_pk_bf16(v1[0], v1[1]); w.w = cvt_pk_bf16(v1[2], v1[3]);
                    *(u32x4*)(rowp + bj * HALF) = w; } }
    }
    __device__ __forceinline__ void operator()(const f32x4 (&acc)[2][2][4][2], const Unit& u, int wr, int wc, int fr, int fq) const {
        const int pn = u.pn;
        if (pn < 8) run<1>(acc, u, wr, wc, fr, fq);
        else if (pn < 12 || pn >= 20) run<2>(acc, u, wr, wc, fr, fq);
        else if (pn < 14) run<3>(acc, u, wr, wc, fr, fq);
        else run<0>(acc, u, wr, wc, fr, fq);
    }
};
struct EpiF32 {
    static constexpr bool PERM = false, AFTER_DRAIN = false;
    float* O; int ldc;
    __device__ __forceinline__ void operator()(const f32x4 (&acc)[2][2][4][2], const Unit& u, int wr, int wc, int fr, int fq) const {
        const int row0 = u.pm * BM + wr * 64 + fr, col0 = u.pn * BM + wc * 32 + 4 * fq;
#pragma unroll
        for (int ai = 0; ai < 2; ++ai)
#pragma unroll
            for (int m = 0; m < 4; ++m) { float* rowp = O + (size_t)(row0 + ai * HALF + m * 16) * ldc + col0;
#pragma unroll
                for (int bj = 0; bj < 2; ++bj)
#pragma unroll
                    for (int n = 0; n < 2; ++n) *(f32x4*)(rowp + bj * HALF + n * 16) = acc[ai][bj][m][n]; }
    }
};

template <class Epi, class Sched, bool ALIGN_EPI = false>
__device__ __forceinline__ void gemm_phase(PG8_LAS unsigned char* lds, const Gemm g, const Sched& S, const Epi& E) {
    const int tid = threadIdx.x, wid = __builtin_amdgcn_readfirstlane(tid >> 6), lane = tid & 63, wr = wid >> 2, wc = wid & 3, fr = lane & 15, fq = lane >> 4;
    const int K = g.K, nt = K / BK, lda = g.lda, ksplit = g.ksplit;
    unsigned voffA[2], voffB[2];
#pragma unroll
    for (int i = 0; i < 2; ++i) { int R, C; stage_rc(tid * 16 + i * 8192, R, C); const int Rb = Epi::PERM ? ((R & ~31) + perm32(R & 31)) : R;
        voffA[i] = (unsigned)(R * lda + C) * 2u; voffB[i] = (unsigned)(Rb * K + C) * 2u; }
    const size_t kstep = (size_t)(BK * 2);
    const size_t hstepA = (size_t)HALF * lda * 2, hstepB = (size_t)HALF * K * 2;
    const size_t tstepA = 2 * hstepA, tstepB = 2 * hstepB;
    const unsigned ldsw = (unsigned)wid * 1024u;
    const int aoff = lds_byte(wr * 64 + fr, fq * 8), boff = lds_byte(wc * 32 + fr, fq * 8);
#define PG8_SA(b, h) (((b) * 2 + (h)) * HTB)
#define PG8_SB(b, h) ((4 + (b) * 2 + (h)) * HTB)
#define PG8_STAGE(bufoff, gbase, voff) do { _Pragma("unroll") for (int _i = 0; _i < 2; ++_i) \
        __builtin_amdgcn_global_load_lds((const unsigned*)((const char*)(gbase) + (voff)[_i]), (PG8_LAS unsigned*)(lds + (bufoff) + ldsw + _i * 8192), 16, 0, 0); } while (0)
#define PG8_LDA(dst, b, h) do { _Pragma("unroll") for (int m = 0; m < 4; ++m) _Pragma("unroll") for (int k = 0; k < 2; ++k) dst[m][k] = *(const PG8_LAS bf16x8*)(lds + PG8_SA(b, h) + aoff + m * 2048 + k * 1024); } while (0)
#define PG8_LDB(dst, b, h) do { _Pragma("unroll") for (int n = 0; n < 2; ++n) _Pragma("unroll") for (int k = 0; k < 2; ++k) dst[n][k] = *(const PG8_LAS bf16x8*)(lds + PG8_SB(b, h) + boff + n * 2048 + k * 1024); } while (0)
#define PG8_MMA(ai, bj, At, Bt) do { __builtin_amdgcn_s_setprio(1); _Pragma("unroll") for (int m = 0; m < 4; ++m) _Pragma("unroll") for (int n = 0; n < 2; ++n) _Pragma("unroll") for (int k = 0; k < 2; ++k) \
        acc[ai][bj][m][n] = __builtin_amdgcn_mfma_f32_16x16x32_bf16(Bt[n][k], At[m][k], acc[ai][bj][m][n], 0, 0, 0); __builtin_amdgcn_s_setprio(0); } while (0)
#define PG8_WAIT_V(n) asm volatile("s_waitcnt vmcnt(" #n ")" ::: "memory")
#define PG8_WAIT_L(n) asm volatile("s_waitcnt lgkmcnt(" #n ")" ::: "memory")
#define PG8_BAR __builtin_amdgcn_s_barrier()
#define PG8_SCHED __builtin_amdgcn_sched_barrier(0)
#define PG8_TA(t) (((t) < ksplit ? cA : cA2) + (size_t)(t) * kstep)
    Unit cur, nxt; int ui = 0;
    if (!S.next(0, cur)) return;
    f32x4 acc[2][2][4][2];
#pragma unroll
    for (int a = 0; a < 2; ++a)
#pragma unroll
        for (int b = 0; b < 2; ++b)
#pragma unroll
            for (int m = 0; m < 4; ++m)
#pragma unroll
                for (int n = 0; n < 2; ++n) acc[a][b][m][n] = (f32x4){0.f, 0.f, 0.f, 0.f};
    bf16x8 At[4][2], B0[2][2], B1[2][2];
    const size_t seg2 = (size_t)ksplit * kstep;
    const char* cA = (const char*)g.A + (size_t)cur.pm * tstepA; const char* cA2 = (const char*)g.A2 + (size_t)cur.pm * tstepA - seg2; const char* cB = (const char*)g.Bt + (size_t)cur.pn * tstepB;
    S.a_ready(cur);
    PG8_STAGE(PG8_SB(0, 0), cB, voffB); PG8_STAGE(PG8_SB(0, 1), cB + hstepB, voffB); PG8_STAGE(PG8_SA(0, 0), cA, voffA); PG8_STAGE(PG8_SA(0, 1), cA + hstepA, voffA);
    if (wr == 1) PG8_BAR;
    PG8_WAIT_V(2); PG8_BAR;
    PG8_STAGE(PG8_SB(1, 0), cB + kstep, voffB); PG8_STAGE(PG8_SA(1, 0), cA + kstep, voffA); PG8_STAGE(PG8_SB(1, 1), cB + hstepB + kstep, voffB);
    PG8_WAIT_V(6); PG8_BAR;
    for (;;) {
        const bool has_next = S.next(ui + 1, nxt);
        const char* nA = has_next ? (const char*)g.A + (size_t)nxt.pm * tstepA : cA; const char* nB = has_next ? (const char*)g.Bt + (size_t)nxt.pn * tstepB : cB;
        for (int t = 0; t < nt; t += 2) {
            const bool last = (t == nt - 2);
            const char* a1 = PG8_TA(t + 1);
            const char* a2 = last ? nA : PG8_TA(t + 2); const char* b2 = last ? nB : cB + (size_t)(t + 2) * kstep;
            const char* a3 = last ? nA + kstep : PG8_TA(t + 3); const char* b3 = b2 + kstep;
            if (last && has_next) S.a_ready(nxt);
            PG8_LDB(B0, 0, 0); PG8_LDB(B1, 0, 1); PG8_SCHED; PG8_LDA(At, 0, 0); PG8_STAGE(PG8_SA(1, 1), a1 + hstepA, voffA);
            PG8_WAIT_V(8); PG8_WAIT_L(0); PG8_BAR; PG8_MMA(0, 0, At, B0); PG8_MMA(0, 1, At, B1); PG8_BAR; PG8_SCHED;
            PG8_LDA(At, 0, 1); PG8_STAGE(PG8_SB(0, 0), b2, voffB); PG8_STAGE(PG8_SB(0, 1), b2 + hstepB, voffB); PG8_STAGE(PG8_SA(0, 0), a2, voffA);
            PG8_WAIT_V(8); PG8_WAIT_L(0); PG8_BAR; PG8_MMA(1, 0, At, B0); PG8_MMA(1, 1, At, B1); PG8_BAR; PG8_SCHED;
            PG8_LDB(B0, 1, 0); PG8_LDB(B1, 1, 1); PG8_SCHED; PG8_LDA(At, 1, 0); PG8_STAGE(PG8_SA(0, 1), a2 + hstepA, voffA);
            PG8_WAIT_V(8); PG8_WAIT_L(0); PG8_BAR; PG8_MMA(0, 0, At, B0); PG8_MMA(0, 1, At, B1); PG8_BAR; PG8_SCHED;
            PG8_LDA(At, 1, 1); PG8_STAGE(PG8_SB(1, 0), b3, voffB); PG8_STAGE(PG8_SB(1, 1), b3 + hstepB, voffB); PG8_STAGE(PG8_SA(1, 0), a3, voffA);
            PG8_WAIT_V(8); PG8_WAIT_L(0); PG8_BAR; PG8_MMA(1, 0, At, B0); PG8_MMA(1, 1, At, B1); PG8_BAR; PG8_SCHED;
        }
        if constexpr (ALIGN_EPI) { if (wr == 0) PG8_BAR; }
        if constexpr (!Epi::AFTER_DRAIN) { E(acc, cur, wr, wc, fr, fq); S.done(cur); }
        if (!has_next) break;
#pragma unroll
        for (int a = 0; a < 2; ++a)
#pragma unroll
            for (int b = 0; b < 2; ++b)
#pragma unroll
                for (int m = 0; m < 4; ++m)
#pragma unroll
                    for (int n = 0; n < 2; ++n) acc[a][b][m][n] = (f32x4){0.f, 0.f, 0.f, 0.f};
        cur = nxt; cA = nA; cA2 = (const char*)g.A2 + (size_t)nxt.pm * tstepA - seg2; cB = nB; ++ui;
        if constexpr (ALIGN_EPI) { if (wr == 1) PG8_BAR; }
    }
    PG8_WAIT_V(0);
    if constexpr (!ALIGN_EPI) { if (wr == 0) PG8_BAR; }
    PG8_BAR;
    if constexpr (Epi::AFTER_DRAIN) { E.fused(acc, cur, wr, wc, fr, fq, lds, wid, lane); S.done(cur); }
#undef PG8_SA
#undef PG8_SB
#undef PG8_STAGE
#undef PG8_LDA
#undef PG8_LDB
#undef PG8_MMA
#undef PG8_WAIT_V
#undef PG8_WAIT_L
#undef PG8_BAR
#undef PG8_SCHED
#undef PG8_TA
}
}
#define GAS __attribute__((address_space(1)))
#define LAS __attribute__((address_space(3)))
typedef unsigned short bf16;
typedef unsigned v4u __attribute__((ext_vector_type(4)));
typedef float f32x4 __attribute__((ext_vector_type(4)));
typedef short bf16x8 __attribute__((ext_vector_type(8)));
typedef GAS unsigned gu32;
typedef GAS unsigned long long gu64;
#define RLX_AGENT __ATOMIC_RELAXED, __HIP_MEMORY_SCOPE_AGENT
#define LDS_WAIT() asm volatile("s_waitcnt lgkmcnt(0)" ::: "memory")
#define VM_WAIT() asm volatile("s_waitcnt vmcnt(0)" ::: "memory")
__device__ __forceinline__ unsigned long long rt() { return __builtin_amdgcn_s_memrealtime(); }
__device__ __forceinline__ unsigned f2bf(float f) { unsigned u = __builtin_bit_cast(unsigned, f); return (u + 0x7fffu + ((u >> 16) & 1u)) >> 16; }
__device__ __forceinline__ unsigned pk2(float lo, float hi) { return f2bf(lo) | (f2bf(hi) << 16); }

#define XB_TMO      128
#define XB_XCNT(j)  (256  + 64 * (j))
#define XB_XSUB(j)  (1280 + 64 * (j))
#define XB_XGEN(j)  (2304 + 64 * (j))
#define XB_TOP      3328
#define XB_TOPGEN   3392
#define XCD_BAR_WORDS 3456
#define XB_SPIN_CAP (1u << 18)

__device__ __forceinline__ unsigned xb_ld(unsigned* p)              { return __hip_atomic_load(p, __ATOMIC_RELAXED, __HIP_MEMORY_SCOPE_AGENT); }
__device__ __forceinline__ unsigned xb_add(unsigned* p, unsigned v) { return __hip_atomic_fetch_add(p, v, __ATOMIC_RELAXED, __HIP_MEMORY_SCOPE_AGENT); }
__device__ __forceinline__ unsigned xb_xcc_id() { return (unsigned)__builtin_amdgcn_s_getreg((3 << 11) | 20) & 0xFu; }
#define XB_SPIN(cond, bar) do { unsigned _sp = 0; while (cond) { __builtin_amdgcn_s_sleep(1); \
    if ((++_sp & 255u) == 0u) { if (xb_ld(&(bar)[XB_TMO])) break; if (_sp > XB_SPIN_CAP) { atomicAdd(&(bar)[XB_TMO], 1u); break; } } } } while (0)

struct XcdBarrier {
    unsigned* bar; unsigned x;
    volatile LAS unsigned* st;
};

__device__ __forceinline__ XcdBarrier xcd_barrier_post(unsigned* bar, volatile LAS unsigned* st) {
    XcdBarrier b; b.bar = bar; b.x = xb_xcc_id(); b.st = st;
    if (threadIdx.x == 0) (void)xb_add(&bar[XB_XCNT(b.x)], 1u);
    return b;
}
__device__ __forceinline__ void xcd_barrier_complete(unsigned* bar, unsigned x, unsigned& nloc, unsigned& nx) {
    const unsigned G = gridDim.x * gridDim.y * gridDim.z;
    unsigned sum, cnt, mine, sp = 0u;
    for (;;) {
        sum = 0u; cnt = 0u; mine = 0u;
#pragma unroll
        for (unsigned j = 0; j < 16; ++j) { const unsigned c = xb_ld(&bar[XB_XCNT(j)]); sum += c; cnt += (c > 0u) ? 1u : 0u; mine = (j == x) ? c : mine; }
        if (sum == G) break;
        __builtin_amdgcn_s_sleep(1);
        if ((++sp & 255u) == 0u) { if (xb_ld(&bar[XB_TMO])) break; if (sp > XB_SPIN_CAP) { atomicAdd(&bar[XB_TMO], 1u); break; } }
    }
    nloc = mine > 0u ? mine : 1u; nx = cnt > 0u ? cnt : 1u;
}

__device__ __forceinline__ void xcd_barrier(const XcdBarrier& b) {
    asm volatile("s_waitcnt vmcnt(0)" ::: "memory");
    __syncthreads();
    if (threadIdx.x == 0) {
        unsigned* bar = b.bar;
        __builtin_amdgcn_s_waitcnt(0);
        unsigned nloc = b.st[0], nx = b.st[1];
        if (nloc == 0u) { xcd_barrier_complete(bar, b.x, nloc, nx); b.st[0] = nloc; b.st[1] = nx; }
        const unsigned old = xb_add(&bar[XB_XSUB(b.x)], 1u);
        const unsigned gen = old / nloc;
        if (old + 1u == (gen + 1u) * nloc) {
            __builtin_amdgcn_fence(__ATOMIC_RELEASE, "agent");
            asm volatile("s_waitcnt vmcnt(0)" ::: "memory");
            const unsigned og = xb_add(&bar[XB_TOP], 1u);
            const unsigned tg = og / nx;
            if (og + 1u == (tg + 1u) * nx) xb_add(&bar[XB_TOPGEN], 1u);
            else XB_SPIN(xb_ld(&bar[XB_TOPGEN]) == tg, bar);
            __builtin_amdgcn_fence(__ATOMIC_ACQUIRE, "agent");
            xb_add(&bar[XB_XGEN(b.x)], 1u);
            asm volatile("s_waitcnt vmcnt(0)" ::: "memory");
        } else {
            XB_SPIN(xb_ld(&bar[XB_XGEN(b.x)]) == gen, bar);
            __builtin_amdgcn_fence(__ATOMIC_ACQUIRE, "agent");
            asm volatile("s_waitcnt vmcnt(0)" ::: "memory");
        }
    }
    __syncthreads();
}

constexpr int NWAVES = 8;
constexpr int BATCH = 8, SEQ = 2048, DM = 1024, M = BATCH * SEQ;
constexpr int D_A = 1024, D_B = 1024, DMIX = 2048, NG = 8, GD = 128, ACH = 128, NH = 4, DK = 128, DV = 256, RANK = 16, BCH = 64;
constexpr int D_IN = 6160, NZ = 6144;
constexpr int ZU = 0, ZV = 1024, ZGA = 2048, ZQ = 3072, ZK = 3584, ZVB = 4096, ZGB = 5120;
constexpr float EPS = 1e-6f;
#ifndef MK_N_LAUNCHES
#define MK_N_LAUNCHES 1
#endif
constexpr int NPH = 6;
constexpr int N_LAUNCHES = MK_N_LAUNCHES;

constexpr size_t MiB = 1u << 20;
constexpr size_t WS_CTL = 0, CTL_ZERO_BYTES = 1 * MiB;
constexpr size_t WS_WIN = 1 * MiB;
constexpr size_t WS_WOUT = 13 * MiB;
constexpr size_t WS_WS = 17 * MiB;
constexpr size_t WS_LR = 18 * MiB;
constexpr size_t WS_SSP = 19 * MiB;
constexpr size_t WS_H = 24 * MiB;
constexpr size_t WS_GQB = 24 * MiB;
constexpr size_t WS_GP = 41 * MiB, WS_GDEC = 50 * MiB;
constexpr size_t OUT_GVT = 0, OUT_GKDT = 36 * MiB;
constexpr size_t WS_Z = 56 * MiB;
constexpr size_t WS_END = 248 * MiB;
constexpr int CW_TMO = 0, CW_CODE = 1, CW_BAR = 4096;

constexpr int RING_OFF = 0, RING_BYTES = 131072;
constexpr int LDSCTL_OFF = RING_BYTES, MISC_OFF = LDSCTL_OFF + 320;
constexpr int LDS_BYTES = 147456;

__device__ __forceinline__ float wave_sum(float v) {
#pragma unroll
    for (int o = 1; o < 64; o <<= 1) v += __shfl_xor(v, o);
    return v;
}
__device__ __forceinline__ float bf2f(unsigned short b) { return __builtin_bit_cast(float, (unsigned)b << 16); }
__device__ __forceinline__ float bflo(unsigned w) { return __builtin_bit_cast(float, w << 16); }
__device__ __forceinline__ float bfhi(unsigned w) { return __builtin_bit_cast(float, w & 0xffff0000u); }
__device__ __forceinline__ f32x4 mfma16(bf16x8 a, bf16x8 b, f32x4 c) { return __builtin_amdgcn_mfma_f32_16x16x32_bf16(a, b, c, 0, 0, 0); }
__device__ __forceinline__ bf16x8 ldfrag(const LAS bf16* X, int pitch, int row0, int k0, int fr, int fq) { return *(const LAS bf16x8*)(X + (row0 + fr) * pitch + k0 + 8 * fq); }

__device__ __forceinline__ void p0_transpose_item(const float* W, int K, int ldw, int nblk, bf16* WT, LAS float* scr, int item, int lane) {
    const int kb = item / nblk, nb = item % nblk, k0 = 64 * kb, n0 = 32 * nb;
#pragma unroll 8
    for (int i = 0; i < 32; ++i) { const int kk = 2 * i + (lane >> 5); scr[kk * 33 + (lane & 31)] = W[(size_t)(k0 + kk) * ldw + n0 + (lane & 31)]; }
    LDS_WAIT(); asm volatile("" ::: "memory");
    const int c = lane & 7;
#pragma unroll
    for (int j = 0; j < 4; ++j) { const int n = (lane >> 3) + 8 * j; const LAS float* s = scr + (8 * c) * 33 + n;
        v4u o; o.x = pk2(s[0 * 33], s[1 * 33]); o.y = pk2(s[2 * 33], s[3 * 33]); o.z = pk2(s[4 * 33], s[5 * 33]); o.w = pk2(s[6 * 33], s[7 * 33]);
        *(GAS v4u*)(WT + (size_t)(n0 + n) * K + k0 + 8 * c) = o; }
    LDS_WAIT(); asm volatile("" ::: "memory");
}
__device__ __forceinline__ void p0_row(const float* xrow, const float* g, bf16* hrow, float* lrrow, const LAS float* wT, int lane) {
    const GAS f32x4* xr = (const GAS f32x4*)xrow + lane; const GAS f32x4* gr = (const GAS f32x4*)g + lane;
    f32x4 v[4]; float s = 0.f;
#pragma unroll
    for (int j = 0; j < 4; ++j) { v[j] = xr[64 * j]; s += (v[j].x * v[j].x + v[j].y * v[j].y) + (v[j].z * v[j].z + v[j].w * v[j].w); }
    const float rs = 1.0f / sqrtf(wave_sum(s) * (1.f / DM) + EPS);
#pragma unroll
    for (int j = 0; j < 4; ++j) { const f32x4 gg = gr[64 * j]; v[j] = v[j] * rs * gg; }
    GAS unsigned long long* o8 = (GAS unsigned long long*)hrow + lane;
#pragma unroll
    for (int j = 0; j < 4; ++j) o8[64 * j] = (unsigned long long)pk2(v[j].x, v[j].y) | ((unsigned long long)pk2(v[j].z, v[j].w) << 32);
    float p[16];
#pragma unroll
    for (int r = 0; r < 16; ++r) { float a = 0.f;
#pragma unroll
        for (int j = 0; j < 4; ++j) { const f32x4 w = *(const LAS f32x4*)(wT + r * 1024 + 256 * j + 4 * lane); a += (v[j].x * w.x + v[j].y * w.y) + (v[j].z * w.z + v[j].w * w.w); }
        p[r] = a; if ((r & 3) == 3) asm volatile("" ::: "memory"); }
    float q8[8], q4[4], q2[2], q1;
    { const bool hi = lane & 1;
#pragma unroll
      for (int i = 0; i < 8; ++i) { const float keep = hi ? p[2 * i + 1] : p[2 * i], send = hi ? p[2 * i] : p[2 * i + 1]; q8[i] = keep + __shfl_xor(send, 1); } }
    { const bool hi = lane & 2;
#pragma unroll
      for (int i = 0; i < 4; ++i) { const float keep = hi ? q8[2 * i + 1] : q8[2 * i], send = hi ? q8[2 * i] : q8[2 * i + 1]; q4[i] = keep + __shfl_xor(send, 2); } }
    { const bool hi = lane & 4;
#pragma unroll
      for (int i = 0; i < 2; ++i) { const float keep = hi ? q4[2 * i + 1] : q4[2 * i], send = hi ? q4[2 * i] : q4[2 * i + 1]; q2[i] = keep + __shfl_xor(send, 4); } }
    { const bool hi = lane & 8; const float keep = hi ? q2[1] : q2[0], send = hi ? q2[0] : q2[1]; q1 = keep + __shfl_xor(send, 8); }
    q1 += __shfl_xor(q1, 16); q1 += __shfl_xor(q1, 32);
    if (lane < 16) lrrow[lane] = q1;
}
__device__ __forceinline__ void p0_prologue(const float* x, const float* pre_g, const float* w_in, const float* w_out, const float* a_w_s,
                                            bf16* WinT, bf16* WoutT, bf16* WSm, bf16* H, float* LR, LAS unsigned char* lds, int vcu, int G, int tid, int wave, int lane) {
    LAS float* scr = (LAS float*)(lds + RING_OFF + wave * 16384);
    const int gw = vcu * NWAVES + wave, NGW = G * NWAVES;
    constexpr int I_IN = (DM / 64) * (NZ / 32), I_OUT = (DMIX / 64) * (DM / 32);
    for (int it = gw; it < I_IN + I_OUT; it += NGW) {
        if (it < I_IN) p0_transpose_item(w_in, DM, D_IN, NZ / 32, WinT, scr, it, lane);
        else p0_transpose_item(w_out, DMIX, DM, DM / 32, WoutT, scr, it - I_IN, lane);
    }
    for (int i = vcu * 512 + tid; i < NG * ACH * ACH; i += G * 512) { const int t = (i >> 7) & 127, s = i & 127; WSm[i] = (bf16)f2bf(s <= t ? a_w_s[i] : 0.f); }
    __syncthreads();
    LAS float* wT = (LAS float*)(lds + RING_OFF);
    for (int i = tid; i < 16 * 1024; i += 512) { const int k = i >> 4, r = i & 15; wT[r * 1024 + k] = w_in[(size_t)k * D_IN + NZ + r]; }
    __syncthreads();
    for (int m = gw; m < M; m += NGW) p0_row(x + (size_t)m * DM, pre_g, H + (size_t)m * DM, LR + (size_t)m * 16, wT, lane);
    __syncthreads();
}

constexpr int SG_P = 136;
__device__ __forceinline__ void sgu_phase(bf16* Z, const bf16* WSm, const float* ln_g, const float* ln_b, const float* b_s, LAS unsigned char* lds, int vcu, int G, int tid, int wave, int lane) {
    LAS bf16* vnT = (LAS bf16*)(lds);
    LAS bf16* Wl = (LAS bf16*)(lds + 128 * SG_P * 2);
    LAS float* st = (LAS float*)(lds + 2 * 128 * SG_P * 2);
    const int fr = lane & 15, fq = lane >> 4;
    for (int unit = vcu; unit < 256; unit += G) {
        const int cb = unit >> 1, half = unit & 1, R0 = cb * ACH;
        for (int rr = 0; rr < 16; ++rr) { const int row = wave * 16 + rr; const bf16* vp = Z + (size_t)(R0 + row) * NZ + ZV;
            const v4u a = *(const GAS v4u*)(vp + 8 * lane), b = *(const GAS v4u*)(vp + 512 + 8 * lane);
            float s = 0.f, q = 0.f;
#pragma unroll
            for (int e = 0; e < 4; ++e) { const float x0 = bflo(a[e]), x1 = bfhi(a[e]), x2 = bflo(b[e]), x3 = bfhi(b[e]); s += (x0 + x1) + (x2 + x3); q += (x0 * x0 + x1 * x1) + (x2 * x2 + x3 * x3); }
            s = wave_sum(s); q = wave_sum(q);
            const float mean = s * (1.f / D_A); float var = q * (1.f / D_A) - mean * mean; var = var > 0.f ? var : 0.f;
            if (lane == 0) { st[2 * row] = mean; st[2 * row + 1] = 1.0f / sqrtf(var + EPS); } }
        __syncthreads();
        for (int gi = 0; gi < 4; ++gi) { const int g = half * 4 + gi;
#pragma unroll
            for (int it = 0; it < 4; ++it) { { const int idx = tid + 512 * it, r = idx >> 4, cblk = idx & 15;
                *(LAS v4u*)(Wl + r * SG_P + 8 * cblk) = *(const GAS v4u*)(WSm + (size_t)g * ACH * ACH + r * 128 + 8 * cblk); }
                const int r = lane + 64 * (wave & 1), cblk = (wave >> 1) + 4 * it;
                const v4u vv = *(const GAS v4u*)(Z + (size_t)(R0 + r) * NZ + ZV + g * GD + 8 * cblk);
                const float mean = st[2 * r], rstd = st[2 * r + 1]; const int c0 = 8 * cblk;
                const f32x4 g0 = *(const GAS f32x4*)(ln_g + g * GD + c0), g1 = *(const GAS f32x4*)(ln_g + g * GD + c0 + 4), b0 = *(const GAS f32x4*)(ln_b + g * GD + c0), b1 = *(const GAS f32x4*)(ln_b + g * GD + c0 + 4);
                float xn[8];
#pragma unroll
                for (int e = 0; e < 4; ++e) { xn[2 * e] = bflo(vv[e]); xn[2 * e + 1] = bfhi(vv[e]); }
#pragma unroll
                for (int e = 0; e < 8; ++e) { const float gg = e < 4 ? g0[e & 3] : g1[e & 3], bb = e < 4 ? b0[e & 3] : b1[e & 3]; vnT[(c0 + e) * SG_P + r] = (bf16)f2bf((xn[e] - mean) * rstd * gg + bb); } }
            __syncthreads();
            f32x4 acc[8];
#pragma unroll
            for (int tt = 0; tt < 8; ++tt) acc[tt] = (f32x4){0.f, 0.f, 0.f, 0.f};
#pragma unroll
            for (int ks = 0; ks < 4; ++ks) { const bf16x8 a = ldfrag(vnT, SG_P, 16 * wave, 32 * ks, fr, fq);
#pragma unroll
                for (int tt = 0; tt < 8; ++tt) acc[tt] = mfma16(a, ldfrag(Wl, SG_P, 16 * tt, 32 * ks, fr, fq), acc[tt]); }
#pragma unroll
            for (int tt = 0; tt < 8; ++tt) { const int t = 16 * tt + fr; const size_t off = (size_t)(R0 + t) * NZ + g * GD + 16 * wave + 4 * fq;
                const pg8::u32x2 uu = *(const GAS pg8::u32x2*)(Z + off + ZU), gg = *(const GAS pg8::u32x2*)(Z + off + ZGA); const float bs = b_s[g * ACH + t];
                const float o0 = bflo(uu.x) * (acc[tt][0] + bs) * bflo(gg.x), o1 = bfhi(uu.x) * (acc[tt][1] + bs) * bfhi(gg.x), o2 = bflo(uu.y) * (acc[tt][2] + bs) * bflo(gg.y), o3 = bfhi(uu.y) * (acc[tt][3] + bs) * bfhi(gg.y);
                pg8::u32x2 w; w.x = pk2(o0, o1); w.y = pk2(o2, o3); *(GAS pg8::u32x2*)(Z + off + ZU) = w; }
            __syncthreads();
        }
    }
}

constexpr int GL_P = 136, GL_PJ = 72;
constexpr int GQB_U = 64 * GL_P, GKDT_U = 128 * GL_PJ, GP_U = 64 * GL_PJ, GVT_U = 256 * GL_PJ;
constexpr float LOG2E = 1.4426950408889634f;
__device__ __forceinline__ void gla_prep(const bf16* Z, const float* LR, const float* w_a2, const float* b_a2, bf16* GQB, bf16* GKDT, bf16* GP, bf16* GVT, float* GDEC,
                                         LAS unsigned char* lds, int vcu, int G, int tid, int wave, int lane) {
    LAS bf16* Qs = (LAS bf16*)(lds);
    LAS bf16* Ks = Qs + 64 * GL_P;
    LAS float* LRs = (LAS float*)(Ks + 64 * GL_P);
    LAS float* tot = LRs + 64 * 16;
    const int fr = lane & 15, fq = lane >> 4;
    const int d = tid & 127, iq = tid >> 7;
    for (int unit = vcu; unit < 1024; unit += G) {
        const int bh = unit >> 5, n = unit & 31, b = bh >> 2, h = bh & 3, R0 = b * SEQ + n * BCH;
        float wa[16];
#pragma unroll
        for (int r = 0; r < 16; ++r) wa[r] = w_a2[r * 512 + h * DK + d];
        const float ba = b_a2[h * DK + d];
        if (tid < 256) *(LAS f32x4*)(LRs + 4 * tid) = *(const GAS f32x4*)(LR + (size_t)R0 * 16 + 4 * tid);
#pragma unroll
        for (int it = 0; it < 2; ++it) { const int idx = tid + 512 * it, row = idx >> 4, c = idx & 15; const bf16* zp = Z + (size_t)(R0 + row) * NZ + h * DK + 8 * c;
            *(LAS v4u*)(Qs + row * GL_P + 8 * c) = *(const GAS v4u*)(zp + ZQ); *(LAS v4u*)(Ks + row * GL_P + 8 * c) = *(const GAS v4u*)(zp + ZK); }
        { bf16* vt = GVT + (size_t)unit * GVT_U;
#pragma unroll
          for (int it = 0; it < 4; ++it) { const int vc = wave + 8 * it; const v4u vv = *(const GAS v4u*)(Z + (size_t)(R0 + lane) * NZ + ZVB + h * DV + 8 * vc);
#pragma unroll
              for (int e = 0; e < 4; ++e) { vt[(8 * vc + 2 * e) * GL_PJ + lane] = (bf16)(vv[e] & 0xffffu); vt[(8 * vc + 2 * e + 1) * GL_PJ + lane] = (bf16)(vv[e] >> 16); } } }
        __syncthreads();
        float c[16]; float run = 0.f;
#pragma unroll
        for (int ii = 0; ii < 16; ++ii) { const int i = 16 * iq + ii; float gl = ba;
#pragma unroll
            for (int r4 = 0; r4 < 4; ++r4) { const f32x4 l4 = *(const LAS f32x4*)(LRs + i * 16 + 4 * r4); gl += (l4.x * wa[4 * r4] + l4.y * wa[4 * r4 + 1]) + (l4.z * wa[4 * r4 + 2] + l4.w * wa[4 * r4 + 3]); }
            run -= __builtin_amdgcn_logf(1.0f + __builtin_amdgcn_exp2f(-gl * LOG2E)) * (1.0f / 16.0f); c[ii] = run; }
        tot[iq * 128 + d] = run;
        __syncthreads();
        const float t0 = tot[d], t1 = tot[128 + d], t2 = tot[256 + d], t3 = tot[384 + d];
        const float off = (iq > 0 ? t0 : 0.f) + (iq > 1 ? t1 : 0.f) + (iq > 2 ? t2 : 0.f), bref = t0 + t1, blast = (t0 + t1) + (t2 + t3);
        unsigned kdp[8]; bf16* qbg = GQB + (size_t)unit * GQB_U;
#pragma unroll
        for (int ii = 0; ii < 16; ++ii) { const int i = 16 * iq + ii; const float bb = c[ii] + off;
            const float q = bf2f(Qs[i * GL_P + d]), k = bf2f(Ks[i * GL_P + d]);
            Qs[i * GL_P + d] = (bf16)f2bf(q * __builtin_amdgcn_exp2f(bb - bref)); Ks[i * GL_P + d] = (bf16)f2bf(k * __builtin_amdgcn_exp2f(bref - bb));
            qbg[i * GL_P + d] = (bf16)f2bf(q * __builtin_amdgcn_exp2f(bb));
            const unsigned kd = f2bf(k * __builtin_amdgcn_exp2f(blast - bb)); if (ii & 1) kdp[ii >> 1] |= kd << 16; else kdp[ii >> 1] = kd; }
        { bf16* kg = GKDT + (size_t)unit * GKDT_U + d * GL_PJ + 16 * iq; *(GAS v4u*)kg = (v4u){kdp[0], kdp[1], kdp[2], kdp[3]}; *(GAS v4u*)(kg + 8) = (v4u){kdp[4], kdp[5], kdp[6], kdp[7]}; }
        if (iq == 0) GDEC[(size_t)unit * 128 + d] = __builtin_amdgcn_exp2f(blast);
        __syncthreads();
        { const int it = wave >> 1; bf16* pg = GP + (size_t)unit * GP_U;
#pragma unroll
          for (int jj = 0; jj < 2; ++jj) { const int jt = 2 * (wave & 1) + jj; f32x4 a = (f32x4){0.f, 0.f, 0.f, 0.f};
#pragma unroll
            for (int ks = 0; ks < 4; ++ks) a = mfma16(ldfrag(Ks, GL_P, 16 * jt, 32 * ks, fr, fq), ldfrag(Qs, GL_P, 16 * it, 32 * ks, fr, fq), a);
            const int i = 16 * it + fr, j0 = 16 * jt + 4 * fq;
            pg8::u32x2 w; w.x = pk2(j0 <= i ? a[0] : 0.f, j0 + 1 <= i ? a[1] : 0.f); w.y = pk2(j0 + 2 <= i ? a[2] : 0.f, j0 + 3 <= i ? a[3] : 0.f);
            *(GAS pg8::u32x2*)(pg + i * GL_PJ + j0) = w; } }
        __syncthreads();
    }
}
constexpr int SQ_QB = 0, SQ_KDT = 17408, SQ_P = SQ_KDT + 18432, SQ_VT = SQ_P + 9216, SQ_GT = SQ_VT + 5120, SQ_DEC = SQ_GT + 4096, SQ_BUF = SQ_DEC + 512;
__device__ __forceinline__ void gla_seq(bf16* Z, const bf16* GQB, const bf16* GKDT, const bf16* GP, const bf16* GVT, const float* GDEC, const float* gn, float* SSP,
                                        LAS unsigned char* lds, int vcu, int G, int tid, int wave, int lane) {
    LAS bf16* SbT = (LAS bf16*)(lds + 2 * SQ_BUF);
    const int fr = lane & 15, fq = lane >> 4;
    for (int unit = vcu; unit < 256; unit += G) {
        const int bh = unit >> 3, dvs = unit & 7, b = bh >> 2, h = bh & 3;
#define GLA_ISSUE(n_, bsel_) do { const int u_ = bh * 32 + (n_); LAS unsigned char* bb_ = lds + (bsel_) * SQ_BUF; \
            for (int wc = wave; wc < 53; wc += 8) { const char* src; int dst; \
                if (wc < 17) { src = (const char*)(GQB + (size_t)u_ * GQB_U) + wc * 1024 + lane * 16; dst = SQ_QB + wc * 1024; } \
                else if (wc < 35) { src = (const char*)(GKDT + (size_t)u_ * GKDT_U) + (wc - 17) * 1024 + lane * 16; dst = SQ_KDT + (wc - 17) * 1024; } \
                else if (wc < 44) { src = (const char*)(GP + (size_t)u_ * GP_U) + (wc - 35) * 1024 + lane * 16; dst = SQ_P + (wc - 35) * 1024; } \
                else if (wc < 49) { src = (const char*)(GVT + (size_t)u_ * GVT_U + dvs * 32 * GL_PJ) + (wc - 44) * 1024 + lane * 16; dst = SQ_VT + (wc - 44) * 1024; } \
                else { const int row = (wc - 49) * 16 + (lane >> 2); src = (const char*)(Z + (size_t)(b * SEQ + (n_) * BCH + row) * NZ + ZGB + h * DV + dvs * 32) + (lane & 3) * 16; dst = SQ_GT + (wc - 49) * 1024; } \
                __builtin_amdgcn_global_load_lds((const unsigned*)src, (LAS unsigned*)(bb_ + dst), 16, 0, 0); } \
            if (wave < 2) __builtin_amdgcn_global_load_lds((const unsigned*)(GDEC + (size_t)u_ * 128 + wave * 64 + lane), (LAS unsigned*)(bb_ + SQ_DEC + wave * 256), 4, 0, 0); } while (0)
        f32x4 S[2] = {(f32x4){0.f, 0.f, 0.f, 0.f}, (f32x4){0.f, 0.f, 0.f, 0.f}};
        for (int i = tid; i < 32 * GL_P / 2; i += 512) ((LAS unsigned*)SbT)[i] = 0u;
        GLA_ISSUE(0, 0);
        asm volatile("s_waitcnt vmcnt(0)" ::: "memory");
        __syncthreads();
        for (int n = 0; n < SEQ / BCH; ++n) {
            const int cur = n & 1, R0 = b * SEQ + n * BCH;
            if (n + 1 < SEQ / BCH) GLA_ISSUE(n + 1, cur ^ 1);
            LAS unsigned char* bb = lds + cur * SQ_BUF;
            const LAS bf16* QB = (const LAS bf16*)(bb + SQ_QB); const LAS bf16* KDT = (const LAS bf16*)(bb + SQ_KDT); const LAS bf16* P = (const LAS bf16*)(bb + SQ_P);
            const LAS bf16* VT = (const LAS bf16*)(bb + SQ_VT); const LAS bf16* GT = (const LAS bf16*)(bb + SQ_GT); const LAS float* dec = (const LAS float*)(bb + SQ_DEC);
            const int it = wave >> 1, vtw = wave & 1; f32x4 o4 = (f32x4){0.f, 0.f, 0.f, 0.f};
#pragma unroll
            for (int ks = 0; ks < 2; ++ks) o4 = mfma16(ldfrag(VT, GL_PJ, 16 * vtw, 32 * ks, fr, fq), ldfrag(P, GL_PJ, 16 * it, 32 * ks, fr, fq), o4);
#pragma unroll
            for (int ks = 0; ks < 4; ++ks) o4 = mfma16(ldfrag(SbT, GL_P, 16 * vtw, 32 * ks, fr, fq), ldfrag(QB, GL_P, 16 * it, 32 * ks, fr, fq), o4);
            { const f32x4 d4 = *(const LAS f32x4*)(dec + 16 * wave + 4 * fq);
#pragma unroll
              for (int vt = 0; vt < 2; ++vt) { S[vt] = S[vt] * d4;
#pragma unroll
                for (int ks = 0; ks < 2; ++ks) S[vt] = mfma16(ldfrag(KDT, GL_PJ, 16 * wave, 32 * ks, fr, fq), ldfrag(VT, GL_PJ, 16 * vt, 32 * ks, fr, fq), S[vt]); } }
            { float ss = (o4[0] * o4[0] + o4[1] * o4[1]) + (o4[2] * o4[2] + o4[3] * o4[3]); ss += __shfl_xor(ss, 16); ss += __shfl_xor(ss, 32);
              const int i = 16 * it + fr, row = R0 + i, col = h * DV + dvs * 32 + 16 * vtw + 4 * fq;
              if (fq == 0) SSP[(size_t)row * 64 + h * 16 + dvs * 2 + vtw] = ss;
              const pg8::u32x2 gg = *(const LAS pg8::u32x2*)(GT + i * 32 + 16 * vtw + 4 * fq); const f32x4 g4 = *(const GAS f32x4*)(gn + col);
              pg8::u32x2 w; w.x = pk2(o4[0] * g4.x * bflo(gg.x), o4[1] * g4.y * bfhi(gg.x)); w.y = pk2(o4[2] * g4.z * bflo(gg.y), o4[3] * g4.w * bfhi(gg.y));
              *(GAS pg8::u32x2*)(Z + (size_t)row * NZ + ZGB + col) = w; }
            __syncthreads();
#pragma unroll
            for (int vt = 0; vt < 2; ++vt) { pg8::u32x2 w; w.x = pk2(S[vt][0], S[vt][1]); w.y = pk2(S[vt][2], S[vt][3]); *(LAS pg8::u32x2*)(SbT + (16 * vt + fr) * GL_P + 16 * wave + 4 * fq) = w; }
            asm volatile("s_waitcnt vmcnt(0)" ::: "memory");
            __syncthreads();
        }
#undef GLA_ISSUE
    }
}

__device__ __forceinline__ void bnorm_phase(bf16* Z, const float* SSP, int vcu, int G, int wave, int lane) {
    const int gw = vcu * NWAVES + wave, NGW = G * NWAVES;
    for (int m = gw; m < M; m += NGW) {
        const int h = lane >> 4; const float* sp = SSP + (size_t)m * 64 + h * 16; float ss = 0.f;
#pragma unroll
        for (int e = 0; e < 4; ++e) { const f32x4 p = *(const GAS f32x4*)(sp + 4 * e); ss += (p.x + p.y) + (p.z + p.w); }
        const float rs = 1.0f / sqrtf(ss * (1.f / DV) + EPS);
        bf16* zp = Z + (size_t)m * NZ + ZGB + 16 * lane;
#pragma unroll
        for (int e = 0; e < 2; ++e) { const v4u a = *(const GAS v4u*)(zp + 8 * e); v4u o;
#pragma unroll
            for (int k = 0; k < 4; ++k) o[k] = pk2(bflo(a[k]) * rs, bfhi(a[k]) * rs);
            *(GAS v4u*)(zp + 8 * e) = o; }
    }
}

__device__ __forceinline__ void final_phase(const float* x, const float* post_g, float* out, int vcu, int G, int wave, int lane) {
    const int gw = vcu * NWAVES + wave, NGW = G * NWAVES;
    for (int m = gw; m < M; m += NGW) {
        GAS f32x4* yr = (GAS f32x4*)(out + (size_t)m * DM) + lane; const GAS f32x4* xr = (const GAS f32x4*)(x + (size_t)m * DM) + lane; const GAS f32x4* gr = (const GAS f32x4*)post_g + lane;
        f32x4 v[4]; float s = 0.f;
#pragma unroll
        for (int j = 0; j < 4; ++j) { v[j] = yr[64 * j]; s += (v[j].x * v[j].x + v[j].y * v[j].y) + (v[j].z * v[j].z + v[j].w * v[j].w); }
        const float rs = 1.0f / sqrtf(wave_sum(s) * (1.f / DM) + EPS);
#pragma unroll
        for (int j = 0; j < 4; ++j) yr[64 * j] = xr[64 * j] + v[j] * rs * gr[64 * j];
    }
}

struct Args { const float* in[12]; float* out; unsigned char* ws; int ph_lo, ph_hi, li, pad; };
__global__ void __launch_bounds__(NWAVES * 64, 2) hyb_fwd(Args args) {
    extern __shared__ __attribute__((aligned(16))) unsigned char lds_raw[];
    LAS unsigned char* lds = (LAS unsigned char*)lds_raw;
    volatile LAS unsigned* MISC = (volatile LAS unsigned*)(lds + MISC_OFF);
    const int tid = threadIdx.x, lane = tid & 63, wave = __builtin_amdgcn_readfirstlane(tid >> 6);
    const int G = gridDim.x; const int bx = blockIdx.x; const int vcu = (G % 8 == 0) ? (bx % 8) * (G / 8) + bx / 8 : bx;
    unsigned char* ws = args.ws;
    gu32* ctl = (gu32*)(ws + WS_CTL);
    const float* x = args.in[0]; const float* pre_g = args.in[1]; const float* w_in = args.in[2]; const float* w_a2 = args.in[3]; const float* b_a2 = args.in[4];
    const float* ln_g = args.in[5]; const float* ln_b = args.in[6]; const float* a_w_s = args.in[7]; const float* a_b_s = args.in[8]; const float* bn_g = args.in[9];
    const float* w_out = args.in[10]; const float* post_g = args.in[11];
    bf16* WinT = (bf16*)(ws + WS_WIN); bf16* WoutT = (bf16*)(ws + WS_WOUT); bf16* WSm = (bf16*)(ws + WS_WS); float* LR = (float*)(ws + WS_LR); float* SSP = (float*)(ws + WS_SSP);
    bf16* H = (bf16*)(ws + WS_H); bf16* Z = (bf16*)(ws + WS_Z);
    for (int u = tid; u < (LDS_BYTES - LDSCTL_OFF) / 4; u += NWAVES * 64) ((LAS unsigned*)(lds + LDSCTL_OFF))[u] = 0u;
    __syncthreads();
    XcdBarrier bar; bar.bar = (unsigned*)(ctl + CW_BAR); bar.x = 0; bar.st = nullptr;
    if (N_LAUNCHES == 1) bar = xcd_barrier_post((unsigned*)(ctl + CW_BAR), MISC + 8);
#define GRID_BAR() do { if (N_LAUNCHES == 1) xcd_barrier(bar); } while (0)
    const int lo = args.ph_lo, hi = args.ph_hi;
#define IN(k) (lo <= (k) && (k) < hi)
    if (IN(0)) { p0_prologue(x, pre_g, w_in, w_out, a_w_s, WinT, WoutT, WSm, H, LR, lds, vcu, G, tid, wave, lane); GRID_BAR(); }
    if (IN(1)) { pg8::Gemm g{H, H, WinT, M, NZ, DM, DM, DM / 64}; pg8::StaticOrder S; S.init(M, NZ, G, bx);
        pg8::EpiZ E{Z, NZ};
        pg8::gemm_phase<pg8::EpiZ, pg8::StaticOrder, true>(lds + RING_OFF, g, S, E); GRID_BAR(); }
    if (IN(2)) { bf16* GQB = (bf16*)(ws + WS_GQB); bf16* GP = (bf16*)(ws + WS_GP); float* GDEC = (float*)(ws + WS_GDEC);
        bf16* GVT = (bf16*)((unsigned char*)args.out + OUT_GVT); bf16* GKDT = (bf16*)((unsigned char*)args.out + OUT_GKDT);
        gla_prep(Z, LR, w_a2, b_a2, GQB, GKDT, GP, GVT, GDEC, lds, vcu, G, tid, wave, lane); GRID_BAR();
        gla_seq(Z, GQB, GKDT, GP, GVT, GDEC, bn_g, SSP, lds, vcu, G, tid, wave, lane);
        sgu_phase(Z, WSm, ln_g, ln_b, a_b_s, lds, vcu, G, tid, wave, lane); GRID_BAR(); }
    if (IN(3)) { bnorm_phase(Z, SSP, vcu, G, wave, lane); GRID_BAR(); }
    if (IN(4)) { pg8::Gemm g{Z + ZU, Z + ZGB, WoutT, M, DM, DMIX, NZ, D_A / 64}; pg8::StaticOrder S; S.init(M, DM, G, bx);
        pg8::EpiF32 E{args.out, DM};
        pg8::gemm_phase<pg8::EpiF32, pg8::StaticOrder, false>(lds + RING_OFF, g, S, E); GRID_BAR(); }
    if (IN(5)) { final_phase(x, post_g, args.out, vcu, G, wave, lane); }
#undef IN
#undef GRID_BAR
}

extern "C" void kernel_launch(void* const* d_in, const int* in_sizes, int n_in, void* d_out, int out_size, void* d_ws, size_t ws_size, hipStream_t stream) {
    static int grid = 0;
    if (grid == 0) {
        if (n_in != 12 || in_sizes[0] != M * DM || out_size != M * DM || ws_size < WS_END) { fprintf(stderr, "kernel_launch: unexpected shapes (n_in %d, in0 %d, out %d, ws %zu); nothing launched\n", n_in, n_in > 0 ? in_sizes[0] : -1, out_size, ws_size); grid = -1; return; }
        int dev = 0, cus = 0, per_cu = 0;
        if (hipGetDevice(&dev) != hipSuccess || hipDeviceGetAttribute(&cus, hipDeviceAttributeMultiprocessorCount, dev) != hipSuccess) { fprintf(stderr, "kernel_launch: device query failed\n"); grid = -1; return; }
        if (hipFuncSetAttribute((const void*)hyb_fwd, hipFuncAttributeMaxDynamicSharedMemorySize, LDS_BYTES) != hipSuccess) { fprintf(stderr, "kernel_launch: hipFuncSetAttribute failed\n"); grid = -1; return; }
        if (hipOccupancyMaxActiveBlocksPerMultiprocessor(&per_cu, (const void*)hyb_fwd, NWAVES * 64, LDS_BYTES) != hipSuccess || per_cu < 1)
            fprintf(stderr, "kernel_launch: note: occupancy query reports %d workgroups per CU\n", per_cu);
        (void)hipGetLastError();
        grid = cus;
    }
    if (grid < 0) return;
    if (hipMemsetAsync((char*)d_ws + WS_CTL, 0, CTL_ZERO_BYTES, stream) != hipSuccess) { fprintf(stderr, "kernel_launch: hipMemsetAsync failed\n"); return; }
    Args a{};
    for (int i = 0; i < 12; ++i) a.in[i] = (const float*)d_in[i];
    a.out = (float*)d_out; a.ws = (unsigned char*)d_ws;
    for (int li = 0; li < N_LAUNCHES; ++li) {
        a.ph_lo = (N_LAUNCHES == 1) ? 0 : li; a.ph_hi = (N_LAUNCHES == 1) ? NPH : li + 1; a.li = li;
        hipLaunchKernelGGL(hyb_fwd, dim3(grid), dim3(NWAVES * 64), LDS_BYTES, stream, a);
        const hipError_t le = hipPeekAtLastError();
        if (le != hipSuccess) { fprintf(stderr, "kernel_launch: launch %d failed: %s\n", li, hipGetErrorName(le)); break; }
    }
}
```
